# Optimizing an MI355X kernel written in HIP

```python
import math
import jax, jax.numpy as jnp
from jax import lax
import numpy as np

D_MODEL = 1024
BATCH = 4
SEQ = 4096
DEPTH = 2

MLA_HEADS = 8
MLA_NOPE = 64
MLA_ROPE = 32
MLA_V = 64
MLA_Q_RANK = 256
MLA_KV_RANK = 128
ROPE_BASE = 10000.0
NSA_HEADS = 8
NSA_KV_HEADS = 2
NSA_DIM = 64
CMP_LEN = 32
CMP_STRIDE = 16
CMP_HIDDEN = 128
SLC_LEN = 64
SLC_TOPK = 16
WINDOW = 512
REL_BUCKETS = 32
REL_MAX_DIST = 128
D_FF = 2816
CONV_WIDTH = 3
PLE_DIM = 256
Q_BLOCK = 128
EPS = 1e-6
NEG = -1e30
POS_BIG = 1e30

IN_SPLITS = (MLA_Q_RANK, MLA_KV_RANK, MLA_ROPE, NSA_HEADS * NSA_DIM,
             NSA_KV_HEADS * NSA_DIM, NSA_KV_HEADS * NSA_DIM,
             NSA_KV_HEADS * NSA_DIM, NSA_KV_HEADS * NSA_DIM,
             NSA_KV_HEADS * NSA_DIM, NSA_KV_HEADS * NSA_DIM,
             3 * NSA_HEADS)
MIX_OUT = MLA_HEADS * MLA_V + NSA_HEADS * NSA_DIM

kernel_name = "hybrid_mla_nsa_convffn_trunk"


def rms_norm(x, g):
    xf = x.astype(jnp.float32)
    y = xf * lax.rsqrt(jnp.mean(xf * xf, axis=-1, keepdims=True) + EPS)
    return (y * g.astype(jnp.float32)).astype(x.dtype)


def rotary(x, cos, sin):
    half = x.shape[-1] // 2
    x1, x2 = x[..., :half], x[..., half:]
    return jnp.concatenate([x1 * cos - x2 * sin, x2 * cos + x1 * sin], axis=-1).astype(x.dtype)


def rel_bucket(dist):
    n = jnp.maximum(dist, 0)
    max_exact = REL_BUCKETS // 2
    large = max_exact + (jnp.log(jnp.maximum(n, 1).astype(jnp.float32) / max_exact)
                         / math.log(REL_MAX_DIST / max_exact)
                         * (REL_BUCKETS - max_exact)).astype(jnp.int32)
    large = jnp.minimum(large, REL_BUCKETS - 1)
    return jnp.where(n < max_exact, n, large)


def mla_attention(c_q, c_kv, k_rope, positions, q_norm, w_uq, kv_norm, w_ukv):
    B, S, _ = c_q.shape
    f32 = jnp.float32
    q = (rms_norm(c_q, q_norm) @ w_uq).reshape(B, S, MLA_HEADS, MLA_NOPE + MLA_ROPE)
    kv = (rms_norm(c_kv, kv_norm) @ w_ukv).reshape(B, S, MLA_HEADS, MLA_NOPE + MLA_V)
    half = MLA_ROPE // 2
    inv = ROPE_BASE ** (-jnp.arange(half, dtype=f32) / half)
    ang = positions.astype(f32)[..., None] * inv
    cos, sin = jnp.cos(ang), jnp.sin(ang)
    q = jnp.concatenate([q[..., :MLA_NOPE],
                         rotary(q[..., MLA_NOPE:], cos[:, :, None, :], sin[:, :, None, :])], axis=-1)
    k_r = rotary(k_rope, cos, sin)
    k = jnp.concatenate([kv[..., :MLA_NOPE],
                         jnp.broadcast_to(k_r[:, :, None, :], (B, S, MLA_HEADS, MLA_ROPE))], axis=-1)
    v = kv[..., MLA_NOPE:]
    q, k, v = (t.transpose(0, 2, 1, 3) for t in (q, k, v))
    scale = (MLA_NOPE + MLA_ROPE) ** -0.5
    kpos = jnp.arange(S)

    def block(i):
        q0 = i * Q_BLOCK
        qb = lax.dynamic_slice_in_dim(q, q0, Q_BLOCK, axis=2)
        s = jnp.einsum('bhqd,bhkd->bhqk', qb, k, preferred_element_type=f32) * scale
        qpos = q0 + jnp.arange(Q_BLOCK)
        s = jnp.where(kpos[None, :] <= qpos[:, None], s, NEG)
        pr = jax.nn.softmax(s, axis=-1)
        return jnp.einsum('bhqk,bhkd->bhqd', pr.astype(v.dtype), v)

    o = lax.map(block, jnp.arange(S // Q_BLOCK))
    return o.transpose(1, 0, 3, 2, 4).reshape(B, S, MLA_HEADS * MLA_V)


def compress_blocks(x, tok, pos_emb, w1, w2):
    B, H = x.shape[0], x.shape[1]
    blk = x[:, :, tok, :] + pos_emb
    blk = blk.reshape(B, H, tok.shape[0], CMP_LEN * NSA_DIM)
    return jax.nn.gelu(blk @ w1, approximate=True) @ w2


def nsa_attention(q, k_cmp, v_cmp, k_slc, v_slc, k_win, v_win, gate_logits,
                  rel_bias, cmp_pos, cmp_w1, cmp_w2):
    B, S, _ = q.shape
    f32 = jnp.float32
    HK = NSA_KV_HEADS
    G = NSA_HEADS // NSA_KV_HEADS
    D = NSA_DIM
    scale = D ** -0.5
    qg = q.reshape(B, S, HK, G, D).transpose(0, 2, 3, 1, 4)

    def kv_heads(t):
        return t.reshape(B, S, HK, D).transpose(0, 2, 1, 3)

    k_cmp, v_cmp, k_slc, v_slc, k_win, v_win = (
        kv_heads(t) for t in (k_cmp, v_cmp, k_slc, v_slc, k_win, v_win))
    gates = jax.nn.sigmoid(gate_logits.reshape(B, S, HK, G, 3).transpose(0, 2, 3, 1, 4))

    n_cmp = (S - CMP_LEN) // CMP_STRIDE + 1
    cmp_start = jnp.arange(n_cmp) * CMP_STRIDE
    tok = cmp_start[:, None] + jnp.arange(CMP_LEN)[None, :]
    kc = compress_blocks(k_cmp, tok, cmp_pos[0], cmp_w1[0], cmp_w2[0])
    vc = compress_blocks(v_cmp, tok, cmp_pos[1], cmp_w1[1], cmp_w2[1])
    cmp_end = cmp_start + CMP_LEN - 1

    n_slc = S // SLC_LEN
    n_sel = min(SLC_TOPK, n_slc)
    ks_blk = k_slc.reshape(B, HK, n_slc, SLC_LEN, D)
    vs_blk = v_slc.reshape(B, HK, n_slc, SLC_LEN, D)
    slc_start = jnp.arange(n_slc) * SLC_LEN
    overlap = jnp.maximum(
        jnp.minimum(cmp_start[:, None] + CMP_LEN, slc_start[None, :] + SLC_LEN)
        - jnp.maximum(cmp_start[:, None], slc_start[None, :]), 0).astype(f32) / CMP_LEN

    pad = ((0, 0), (0, 0), (WINDOW, 0), (0, 0))
    kw_pad = jnp.pad(k_win, pad)
    vw_pad = jnp.pad(v_win, pad)

    table = rel_bias.astype(f32)
    table_g = table.reshape(REL_BUCKETS, HK, G).transpose(1, 0, 2)

    def head_bias(dist):
        bq = table[rel_bucket(dist)]
        return bq.transpose(2, 0, 1).reshape(HK, G, dist.shape[0], dist.shape[1])

    bi = jnp.arange(B)[:, None, None, None]
    hi = jnp.arange(HK)[None, :, None, None]
    blk_ids = jnp.arange(n_slc)

    def chunk(i):
        q0 = i * Q_BLOCK
        qpos = q0 + jnp.arange(Q_BLOCK)
        qb = lax.dynamic_slice_in_dim(qg, q0, Q_BLOCK, axis=3)
        gb = lax.dynamic_slice_in_dim(gates, q0, Q_BLOCK, axis=3)
        dist_c = qpos[:, None] - cmp_end[None, :]
        s_c = jnp.einsum('bhgqd,bhcd->bhgqc', qb, kc, preferred_element_type=f32) * scale + head_bias(dist_c)
        s_c = jnp.where(dist_c >= 0, s_c, NEG)
        p_c = jax.nn.softmax(s_c, axis=-1) * (qpos >= CMP_LEN - 1)[:, None].astype(f32)
        o_c = jnp.einsum('bhgqc,bhcd->bhgqd', p_c.astype(vc.dtype), vc)
        imp = jnp.einsum('bhgqc,cn->bhqn', p_c, overlap)
        q_blk = qpos // SLC_LEN
        forced = ((blk_ids[None, :] == 0) | (blk_ids[None, :] == q_blk[:, None])
                  | (blk_ids[None, :] == q_blk[:, None] - 1))
        imp = jnp.where(forced, POS_BIG, jnp.where(blk_ids[None, :] > q_blk[:, None], NEG, imp))
        _, sel = lax.top_k(imp, n_sel)
        k_g = ks_blk[bi, hi, sel]
        v_g = vs_blk[bi, hi, sel]
        kpos = sel[..., None] * SLC_LEN + jnp.arange(SLC_LEN)
        dist_s = qpos[:, None, None] - kpos
        bias_s = table_g[hi[..., None], rel_bucket(dist_s)].transpose(0, 1, 5, 2, 3, 4)
        s_s = jnp.einsum('bhgqd,bhqnld->bhgqnl', qb, k_g, preferred_element_type=f32) * scale + bias_s
        s_s = jnp.where((dist_s >= 0)[:, :, None], s_s, NEG)
        p_s = jax.nn.softmax(s_s.reshape(s_s.shape[:4] + (-1,)), axis=-1).reshape(s_s.shape)
        o_s = jnp.einsum('bhgqnl,bhqnld->bhgqd', p_s.astype(v_g.dtype), v_g)
        k_w = lax.dynamic_slice_in_dim(kw_pad, q0, Q_BLOCK + WINDOW, axis=2)
        v_w = lax.dynamic_slice_in_dim(vw_pad, q0, Q_BLOCK + WINDOW, axis=2)
        dist_w = qpos[:, None] - (q0 - WINDOW + jnp.arange(Q_BLOCK + WINDOW))[None, :]
        s_w = jnp.einsum('bhgqd,bhkd->bhgqk', qb, k_w, preferred_element_type=f32) * scale + head_bias(dist_w)
        s_w = jnp.where((dist_w >= 0) & (dist_w < WINDOW), s_w, NEG)
        p_w = jax.nn.softmax(s_w, axis=-1)
        o_w = jnp.einsum('bhgqk,bhkd->bhgqd', p_w.astype(v_w.dtype), v_w)
        out = gb[..., 0:1] * o_c + gb[..., 1:2] * o_s + gb[..., 2:3] * o_w
        return out.astype(q.dtype)

    o = lax.map(chunk, jnp.arange(S // Q_BLOCK))
    return o.transpose(1, 0, 4, 2, 3, 5).reshape(B, S, NSA_HEADS * D)


def conv_ffn(h, w_gate, w_up, conv_w, conv_b, w_down):
    S = h.shape[1]
    g = h @ w_gate
    gp = jnp.pad(g, ((0, 0), (CONV_WIDTH - 1, 0), (0, 0)))
    g = sum(conv_w[k] * gp[:, k:k + S] for k in range(CONV_WIDTH)) + conv_b
    return (jax.nn.gelu(g, approximate=True) * (h @ w_up)) @ w_down


def setup_inputs(seed: int = 0) -> dict:
    key = jax.random.key(seed)
    ks = jax.random.split(key, 26)
    f32 = jnp.float32

    def nrm(k, shape, fan_in):
        return jax.random.normal(k, shape, f32) * fan_in ** -0.5

    def gain(k, shape):
        return 1.0 + 0.05 * jax.random.normal(k, shape, f32)

    n_in = sum(IN_SPLITS)
    return {
        "x": jax.random.normal(ks[0], (BATCH, SEQ, D_MODEL), f32),
        "p": jax.random.normal(ks[1], (DEPTH, BATCH, SEQ, PLE_DIM), f32),
        "positions": jnp.tile(jnp.arange(SEQ, dtype=jnp.int32)[None, :], (BATCH, 1)),
        "rel_bias": 0.5 * jax.random.normal(ks[2], (REL_BUCKETS, NSA_HEADS), f32),
        "attn_pre_norm": gain(ks[3], (DEPTH, D_MODEL)),
        "attn_post_norm": gain(ks[4], (DEPTH, D_MODEL)),
        "ffn_pre_norm": gain(ks[5], (DEPTH, D_MODEL)),
        "ffn_post_norm": gain(ks[6], (DEPTH, D_MODEL)),
        "w_in": nrm(ks[7], (DEPTH, D_MODEL, n_in), D_MODEL),
        "mla_q_norm": gain(ks[8], (DEPTH, MLA_Q_RANK)),
        "mla_w_uq": nrm(ks[9], (DEPTH, MLA_Q_RANK, MLA_HEADS * (MLA_NOPE + MLA_ROPE)), MLA_Q_RANK),
        "mla_kv_norm": gain(ks[10], (DEPTH, MLA_KV_RANK)),
        "mla_w_ukv": nrm(ks[11], (DEPTH, MLA_KV_RANK, MLA_HEADS * (MLA_NOPE + MLA_V)), MLA_KV_RANK),
        "nsa_cmp_pos": 0.1 * jax.random.normal(ks[12], (DEPTH, 2, CMP_LEN, NSA_DIM), f32),
        "nsa_cmp_w1": nrm(ks[13], (DEPTH, 2, CMP_LEN * NSA_DIM, CMP_HIDDEN), CMP_LEN * NSA_DIM),
        "nsa_cmp_w2": nrm(ks[14], (DEPTH, 2, CMP_HIDDEN, NSA_DIM), CMP_HIDDEN),
        "w_o": nrm(ks[15], (DEPTH, MIX_OUT, D_MODEL), MIX_OUT),
        "ffn_w_gate": nrm(ks[16], (DEPTH, D_MODEL, D_FF), D_MODEL),
        "ffn_w_up": nrm(ks[17], (DEPTH, D_MODEL, D_FF), D_MODEL),
        "ffn_conv_w": nrm(ks[18], (DEPTH, CONV_WIDTH, D_FF), CONV_WIDTH),
        "ffn_conv_b": 0.02 * jax.random.normal(ks[19], (DEPTH, D_FF), f32),
        "ffn_w_down": nrm(ks[20], (DEPTH, D_FF, D_MODEL), D_FF),
        "ple_proj": nrm(ks[21], (DEPTH, PLE_DIM, D_MODEL), PLE_DIM),
        "ple_gate": nrm(ks[22], (DEPTH, D_MODEL, D_MODEL), D_MODEL),
    }


def reference(x, p, positions, rel_bias, attn_pre_norm, attn_post_norm, ffn_pre_norm,
              ffn_post_norm, w_in, mla_q_norm, mla_w_uq, mla_kv_norm, mla_w_ukv,
              nsa_cmp_pos, nsa_cmp_w1, nsa_cmp_w2, w_o, ffn_w_gate, ffn_w_up,
              ffn_conv_w, ffn_conv_b, ffn_w_down, ple_proj, ple_gate):
    offsets = np.cumsum(IN_SPLITS)[:-1].tolist()
    for i in range(DEPTH):
        h = rms_norm(x, attn_pre_norm[i])
        z = h @ w_in[i]
        (c_q, c_kv, k_rope, q_nsa, k_cmp, v_cmp, k_slc, v_slc,
         k_win, v_win, g_nsa) = jnp.split(z, offsets, axis=-1)
        o_mla = mla_attention(c_q, c_kv, k_rope, positions, mla_q_norm[i], mla_w_uq[i],
                              mla_kv_norm[i], mla_w_ukv[i])
        o_nsa = nsa_attention(q_nsa, k_cmp, v_cmp, k_slc, v_slc, k_win, v_win, g_nsa,
                              rel_bias, nsa_cmp_pos[i], nsa_cmp_w1[i], nsa_cmp_w2[i])
        y = jnp.concatenate([o_mla, o_nsa], axis=-1) @ w_o[i]
        x = x + rms_norm(y, attn_post_norm[i])
        f = conv_ffn(rms_norm(x, ffn_pre_norm[i]), ffn_w_gate[i], ffn_w_up[i],
                     ffn_conv_w[i], ffn_conv_b[i], ffn_w_down[i])
        x = x + rms_norm(f, ffn_post_norm[i])
        x = x + jax.nn.sigmoid(x @ ple_gate[i]) * (p[i] @ ple_proj[i])
    return x
```

```cpp
#include <hip/hip_runtime.h>
#include <hip/hip_cooperative_groups.h>
#include <cstdio>
#include <cstdint>
namespace cg = cooperative_groups;
typedef _Float16 h16;
#define DEVI __device__ __forceinline__

constexpr int NB = 4, S = 4096, DM = 1024, M = NB * S, DEPTH = 2;
constexpr int NZ = 1720, ZP = 1792;
constexpr int FF = 2816, PLE = 256;
constexpr float EPS = 1e-6f;
constexpr float NEGF = -1e30f;
constexpr int ZC_CQ = 0, ZC_CKV = 256, ZC_KR = 384, ZC_QN = 416, ZC_KCMP = 928, ZC_VCMP = 1056, ZC_KSLC = 1184,
              ZC_VSLC = 1312, ZC_KWIN = 1440, ZC_VWIN = 1568, ZC_GATE = 1696;
constexpr int NCMP = 255;

constexpr size_t MiB = 1u << 20;
constexpr size_t WS_XN = 30 * MiB, WS_Z = 62 * MiB, WS_QM = 118 * MiB, WS_KVM = 142 * MiB, WS_KR = 174 * MiB,
                 WS_CQN = 175 * MiB, WS_CKVN = 183 * MiB, WS_KC = 187 * MiB, WS_OA = 188 * MiB, WS_CS = 239 * MiB;
constexpr size_t WS_Y = 62 * MiB, WS_G = 62 * MiB, WS_A = 150 * MiB, WS_F = 62 * MiB, WS_PP = 150 * MiB;
constexpr int LDS_BYTES = 147456;
constexpr int NTHREADS = 512, NWAVES = 8;

__device__ const unsigned char BUCKET_T[128] = {0, 1, 2, 3, 4, 5, 6, 7, 8, 9, 10, 11, 12, 13, 14, 15, 16, 16, 16, 17, 17, 18, 18, 18, 19, 19, 19, 20, 20, 20, 20, 21, 21, 21, 21, 22, 22, 22, 22, 22, 23, 23, 23, 23, 23, 23, 24, 24, 24, 24, 24, 24, 25, 25, 25, 25, 25, 25, 25, 26, 26, 26, 26, 26, 26, 26, 26, 27, 27, 27, 27, 27, 27, 27, 27, 27, 27, 28, 28, 28, 28, 28, 28, 28, 28, 28, 28, 29, 29, 29, 29, 29, 29, 29, 29, 29, 29, 29, 29, 30, 30, 30, 30, 30, 30, 30, 30, 30, 30, 30, 30, 30, 30, 31, 31, 31, 31, 31, 31, 31, 31, 31, 31, 31, 31, 31, 31, 31};
__device__ const double ROPE_INV[16] = {1.0, 0.5623413251903491, 0.31622776601683794, 0.1778279410038923, 0.1, 0.05623413251903491, 0.03162277660168379, 0.01778279410038923, 0.01, 0.005623413251903491, 0.0031622776601683794, 0.0017782794100389228, 0.001, 0.0005623413251903491, 0.00031622776601683794, 0.00017782794100389227};

struct Params { const float* in[24]; float* out; unsigned char* ws; };

DEVI float wave_max(float v) {
#pragma unroll
    for (int o = 32; o; o >>= 1) v = fmaxf(v, __shfl_xor(v, o));
    return v;
}
DEVI float wave_sum(float v) {
#pragma unroll
    for (int o = 32; o; o >>= 1) v += __shfl_xor(v, o);
    return v;
}
#define WSYNC() asm volatile("s_waitcnt lgkmcnt(0)" ::: "memory")
DEVI float gelu_tanh(float x) { return 0.5f * x * (1.f + tanhf(0.7978845608028654f * (x + 0.044715f * x * x * x))); }
DEVI float sigmoidf(float x) { return 1.f / (1.f + expf(-x)); }
DEVI float rel_bias_of(const float* rel_bias, int head, int dist) {
    const int bk = dist < 128 ? (int)BUCKET_T[dist] : 31;
    return rel_bias[bk * 8 + head];
}

template <typename TA, class Epi>
DEVI void gemm_naive(const TA* __restrict__ A, int lda, const float* __restrict__ W, int N, int K, int Mrows, Epi epi, float* sm) {
    float* As = sm;
    float* Bs = sm + 16 * 132;
    const int tid = threadIdx.x, tx = tid & 15, ty = tid >> 4;
    const int ntn = (N + 63) / 64, ntm = Mrows / 128;
    for (int tile = blockIdx.x; tile < ntm * ntn; tile += gridDim.x) {
        const int tm = tile / ntn, tn = tile % ntn;
        const int m0 = tm * 128, n0 = tn * 64;
        float acc[4][4];
#pragma unroll
        for (int i = 0; i < 4; ++i)
#pragma unroll
            for (int j = 0; j < 4; ++j) acc[i][j] = 0.f;
        for (int k0 = 0; k0 < K; k0 += 16) {
            {
                const int r = tid >> 2, kk = (tid & 3) * 4;
                const TA* ap = A + (size_t)(m0 + r) * lda + k0 + kk;
#pragma unroll
                for (int i = 0; i < 4; ++i) As[(kk + i) * 132 + r] = (float)ap[i];
            }
            {
                const int kk = tid >> 5, nn = (tid & 31) * 2;
#pragma unroll
                for (int i = 0; i < 2; ++i) { const int n = n0 + nn + i; Bs[kk * 68 + nn + i] = n < N ? W[(size_t)(k0 + kk) * N + n] : 0.f; }
            }
            __syncthreads();
#pragma unroll 2
            for (int kk = 0; kk < 16; ++kk) {
                float a[4], b[4];
#pragma unroll
                for (int i = 0; i < 4; ++i) a[i] = As[kk * 132 + ty * 4 + i];
#pragma unroll
                for (int j = 0; j < 4; ++j) b[j] = Bs[kk * 68 + tx * 4 + j];
#pragma unroll
                for (int i = 0; i < 4; ++i)
#pragma unroll
                    for (int j = 0; j < 4; ++j) acc[i][j] += a[i] * b[j];
            }
            __syncthreads();
        }
#pragma unroll
        for (int i = 0; i < 4; ++i)
#pragma unroll
            for (int j = 0; j < 4; ++j) { const int m = m0 + ty * 4 + i, n = n0 + tx * 4 + j; if (n < N) epi(m, n, acc[i][j]); }
    }
}

DEVI void ph_norm1(const float* x, const float* g, h16* XN) {
    const int lane = threadIdx.x & 63, gw = blockIdx.x * NWAVES + (threadIdx.x >> 6), NW = gridDim.x * NWAVES;
    for (int m = gw; m < M; m += NW) {
        const float* xr = x + (size_t)m * DM;
        float v[16]; float ss = 0.f;
#pragma unroll
        for (int i = 0; i < 16; ++i) { v[i] = xr[i * 64 + lane]; ss += v[i] * v[i]; }
        ss = wave_sum(ss);
        const float r = rsqrtf(ss * (1.f / DM) + EPS);
#pragma unroll
        for (int i = 0; i < 16; ++i) XN[(size_t)m * DM + i * 64 + lane] = (h16)(v[i] * r * g[i * 64 + lane]);
    }
}
DEVI void ph_prep(const h16* Z, const int* positions, const float* qn, const float* kvn, h16* CQN, h16* CKVN, h16* KR, float* CS) {
    const int lane = threadIdx.x & 63, gw = blockIdx.x * NWAVES + (threadIdx.x >> 6), NW = gridDim.x * NWAVES;
    for (int m = gw; m < M; m += NW) {
        const h16* zr = Z + (size_t)m * ZP;
        {
            float v[4]; float ss = 0.f;
#pragma unroll
            for (int i = 0; i < 4; ++i) { v[i] = (float)zr[ZC_CQ + i * 64 + lane]; ss += v[i] * v[i]; }
            ss = wave_sum(ss);
            const float r = rsqrtf(ss * (1.f / 256.f) + EPS);
#pragma unroll
            for (int i = 0; i < 4; ++i) CQN[(size_t)m * 256 + i * 64 + lane] = (h16)(v[i] * r * qn[i * 64 + lane]);
        }
        {
            float v[2]; float ss = 0.f;
#pragma unroll
            for (int i = 0; i < 2; ++i) { v[i] = (float)zr[ZC_CKV + i * 64 + lane]; ss += v[i] * v[i]; }
            ss = wave_sum(ss);
            const float r = rsqrtf(ss * (1.f / 128.f) + EPS);
#pragma unroll
            for (int i = 0; i < 2; ++i) CKVN[(size_t)m * 128 + i * 64 + lane] = (h16)(v[i] * r * kvn[i * 64 + lane]);
        }
        if (lane < 16) {
            const int pos = positions[m];
            double rev = (double)pos * ROPE_INV[lane] * 0.15915494309189535;
            rev -= rint(rev);
            const float fr = (float)rev;
            const float sn = __builtin_amdgcn_sinf(fr), cs = __builtin_amdgcn_cosf(fr);
            CS[(size_t)m * 32 + lane] = cs; CS[(size_t)m * 32 + 16 + lane] = sn;
            const float x1 = (float)zr[ZC_KR + lane], x2 = (float)zr[ZC_KR + 16 + lane];
            KR[(size_t)m * 32 + lane] = (h16)(x1 * cs - x2 * sn);
            KR[(size_t)m * 32 + 16 + lane] = (h16)(x2 * cs + x1 * sn);
        }
    }
}
DEVI void ph_post1(const float* x, const float* Y, const float* gpost, const float* gpre, float* out, h16* XN) {
    const int lane = threadIdx.x & 63, gw = blockIdx.x * NWAVES + (threadIdx.x >> 6), NW = gridDim.x * NWAVES;
    for (int m = gw; m < M; m += NW) {
        float y[16], v[16]; float ss = 0.f;
#pragma unroll
        for (int i = 0; i < 16; ++i) { y[i] = Y[(size_t)m * DM + i * 64 + lane]; ss += y[i] * y[i]; }
        ss = wave_sum(ss);
        const float r = rsqrtf(ss * (1.f / DM) + EPS);
        float s2 = 0.f;
#pragma unroll
        for (int i = 0; i < 16; ++i) { v[i] = x[(size_t)m * DM + i * 64 + lane] + y[i] * r * gpost[i * 64 + lane]; s2 += v[i] * v[i]; }
        s2 = wave_sum(s2);
        const float r2 = rsqrtf(s2 * (1.f / DM) + EPS);
#pragma unroll
        for (int i = 0; i < 16; ++i) { out[(size_t)m * DM + i * 64 + lane] = v[i]; XN[(size_t)m * DM + i * 64 + lane] = (h16)(v[i] * r2 * gpre[i * 64 + lane]); }
    }
}
DEVI void ph_post2(const float* F, const float* gpost, float* out, h16* X16) {
    const int lane = threadIdx.x & 63, gw = blockIdx.x * NWAVES + (threadIdx.x >> 6), NW = gridDim.x * NWAVES;
    for (int m = gw; m < M; m += NW) {
        float y[16]; float ss = 0.f;
#pragma unroll
        for (int i = 0; i < 16; ++i) { y[i] = F[(size_t)m * DM + i * 64 + lane]; ss += y[i] * y[i]; }
        ss = wave_sum(ss);
        const float r = rsqrtf(ss * (1.f / DM) + EPS);
#pragma unroll
        for (int i = 0; i < 16; ++i) {
            const float v = out[(size_t)m * DM + i * 64 + lane] + y[i] * r * gpost[i * 64 + lane];
            out[(size_t)m * DM + i * 64 + lane] = v; X16[(size_t)m * DM + i * 64 + lane] = (h16)v;
        }
    }
}

DEVI void ph_compress(const h16* Z, const float* cpos, const float* w1, const float* w2, float* KC, float* sm) {
    float* xs = sm;
    float* part = sm + 2048;
    float* hs = sm + 2048 + 512;
    float* part2 = sm + 2048 + 512 + 128;
    const int tid = threadIdx.x;
    const int nitems = 2 * NB * 2 * NCMP;
    for (int it = blockIdx.x; it < nitems; it += gridDim.x) {
        const int c = it % NCMP; int r = it / NCMP; const int hk = r & 1; r >>= 1; const int b = r % NB; const int kv = r / NB;
        const int col0 = (kv == 0 ? ZC_KCMP : ZC_VCMP) + hk * 64;
        for (int i = tid; i < 2048; i += NTHREADS) {
            const int l = i >> 6, d = i & 63;
            xs[i] = (float)Z[(size_t)(b * S + 16 * c + l) * ZP + col0 + d] + cpos[(size_t)kv * 2048 + i];
        }
        __syncthreads();
        {
            const int j = tid & 127, p = tid >> 7;
            const float* wp = w1 + (size_t)kv * 2048 * 128 + (size_t)(p * 512) * 128 + j;
            float a = 0.f;
#pragma unroll 4
            for (int i = 0; i < 512; ++i) a += xs[p * 512 + i] * wp[(size_t)i * 128];
            part[p * 128 + j] = a;
        }
        __syncthreads();
        if (tid < 128) hs[tid] = gelu_tanh(part[tid] + part[128 + tid] + part[256 + tid] + part[384 + tid]);
        __syncthreads();
        {
            const int d = tid & 63, p = tid >> 6;
            const float* wp = w2 + (size_t)kv * 128 * 64 + (size_t)(p * 16) * 64 + d;
            float a = 0.f;
#pragma unroll
            for (int j = 0; j < 16; ++j) a += hs[p * 16 + j] * wp[j * 64];
            part2[p * 64 + d] = a;
        }
        __syncthreads();
        if (tid < 64) {
            float a = 0.f;
#pragma unroll
            for (int p = 0; p < 8; ++p) a += part2[p * 64 + tid];
            KC[((((size_t)kv * NB + b) * 2 + hk) * 256 + c) * 64 + tid] = a;
        }
        __syncthreads();
    }
}

DEVI void mla_item(int b, int h, int qpos, const h16* QM, const h16* KVM, const h16* KR, const float* CS, h16* OA, float* wsm) {
    const int lane = threadIdx.x & 63;
    const int m = b * S + qpos;
    float* qs = wsm; float* pb = wsm + 96;
    WSYNC();
    qs[lane] = (float)QM[(size_t)m * 768 + h * 96 + lane];
    if (lane < 16) {
        const float x1 = (float)QM[(size_t)m * 768 + h * 96 + 64 + lane], x2 = (float)QM[(size_t)m * 768 + h * 96 + 80 + lane];
        const float c = CS[(size_t)m * 32 + lane], s = CS[(size_t)m * 32 + 16 + lane];
        qs[64 + lane] = x1 * c - x2 * s; qs[80 + lane] = x2 * c + x1 * s;
    }
    WSYNC();
    float mrun = -INFINITY, l = 0.f, o = 0.f;
    const float scale = 0.10206207261596577f;
    for (int k0 = 0; k0 <= qpos; k0 += 64) {
        const int key = k0 + lane; const bool valid = key <= qpos;
        float s = -INFINITY;
        if (valid) {
            const h16* kp = KVM + (size_t)(b * S + key) * 1024 + h * 128; const h16* kr = KR + (size_t)(b * S + key) * 32;
            float d = 0.f;
#pragma unroll 8
            for (int i = 0; i < 64; ++i) d += qs[i] * (float)kp[i];
#pragma unroll 8
            for (int i = 0; i < 32; ++i) d += qs[64 + i] * (float)kr[i];
            s = d * scale;
        }
        const float mnew = fmaxf(mrun, wave_max(s));
        const float p = valid ? expf(s - mnew) : 0.f;
        const float corr = expf(mrun - mnew);
        l = l * corr + wave_sum(p);
        WSYNC(); pb[lane] = p; WSYNC();
        o *= corr;
        const int nk = min(64, qpos - k0 + 1);
        for (int j = 0; j < nk; ++j) o += pb[j] * (float)KVM[(size_t)(b * S + k0 + j) * 1024 + h * 128 + 64 + lane];
        mrun = mnew;
    }
    OA[(size_t)m * 1024 + h * 64 + lane] = (h16)(o / l);
}

DEVI void nsa_item(int b, int hk, int qpos, const h16* Z, const float* KC, const float* rel_bias, h16* OA, float* wsm) {
    const int lane = threadIdx.x & 63;
    const int m = b * S + qpos;
    float* qs = wsm;
    float* pb = wsm + 256;
    float* ib = wsm + 256 + 1024;
    const h16* zr = Z + (size_t)m * ZP;
    WSYNC();
#pragma unroll
    for (int g = 0; g < 4; ++g) qs[g * 64 + lane] = (float)zr[ZC_QN + (hk * 4 + g) * 64 + lane];
    WSYNC();
    float gate[4][3];
#pragma unroll
    for (int g = 0; g < 4; ++g)
#pragma unroll
        for (int j = 0; j < 3; ++j) gate[g][j] = sigmoidf((float)zr[ZC_GATE + (hk * 4 + g) * 3 + j]);
    const float* kc = KC + (((size_t)0 * NB + b) * 2 + hk) * 256 * 64;
    const float* vc = KC + (((size_t)1 * NB + b) * 2 + hk) * 256 * 64;
    float oc[4] = {0.f, 0.f, 0.f, 0.f};
    float impv = 0.f;
    if (qpos >= 31) {
        float sc[4][4];
#pragma unroll
        for (int cc = 0; cc < 4; ++cc) {
            const int c = cc * 64 + lane; const int dist = qpos - (16 * c + 31);
            const bool valid = (c < NCMP) && dist >= 0;
            float d[4] = {0.f, 0.f, 0.f, 0.f};
            if (valid) {
                const float* kp = kc + (size_t)c * 64;
#pragma unroll 4
                for (int i = 0; i < 64; ++i) { const float kvv = kp[i];
#pragma unroll
                    for (int g = 0; g < 4; ++g) d[g] += qs[g * 64 + i] * kvv; }
            }
#pragma unroll
            for (int g = 0; g < 4; ++g) sc[g][cc] = valid ? d[g] * 0.125f + rel_bias_of(rel_bias, hk * 4 + g, dist) : -INFINITY;
        }
#pragma unroll
        for (int g = 0; g < 4; ++g) {
            float mx = fmaxf(fmaxf(sc[g][0], sc[g][1]), fmaxf(sc[g][2], sc[g][3]));
            mx = wave_max(mx);
            float e[4]; float sum = 0.f;
#pragma unroll
            for (int cc = 0; cc < 4; ++cc) { e[cc] = expf(sc[g][cc] - mx); sum += e[cc]; }
            sum = wave_sum(sum);
            const float inv = 1.f / sum;
#pragma unroll
            for (int cc = 0; cc < 4; ++cc) pb[g * 256 + cc * 64 + lane] = e[cc] * inv;
        }
        WSYNC();
        const int cmax = min(NCMP, (qpos - 31) / 16 + 1);
        for (int c = 0; c < cmax; ++c) {
            const float vv = vc[(size_t)c * 64 + lane];
#pragma unroll
            for (int g = 0; g < 4; ++g) oc[g] += pb[g * 256 + c] * vv;
        }
        {
            const int n = lane;
#pragma unroll
            for (int g = 0; g < 4; ++g) {
                float a = pb[g * 256 + 4 * n] + pb[g * 256 + 4 * n + 1] + pb[g * 256 + 4 * n + 2];
                if (n > 0) a += 0.5f * pb[g * 256 + 4 * n - 1];
                if (4 * n + 3 < NCMP) a += 0.5f * pb[g * 256 + 4 * n + 3];
                impv += a;
            }
        }
    }
    const int qblk = qpos >> 6;
    unsigned long long selmask;
    {
        const int n = lane;
        float val = impv;
        if (n == 0 || n == qblk || n == qblk - 1) val = 1e30f;
        else if (n > qblk) val = NEGF;
        WSYNC(); ib[n] = val; WSYNC();
        int rank = 0;
        for (int j = 0; j < 64; ++j) { const float vj = ib[j]; rank += (vj > val || (vj == val && j < n)) ? 1 : 0; }
        selmask = __ballot(rank < 16);
    }
    float os[4] = {0.f, 0.f, 0.f, 0.f}, ms[4], ls[4] = {0.f, 0.f, 0.f, 0.f};
#pragma unroll
    for (int g = 0; g < 4; ++g) ms[g] = -INFINITY;
    for (int n = 0; n <= qblk; ++n) {
        if (!((selmask >> n) & 1ull)) continue;
        const int key = n * 64 + lane; const int dist = qpos - key; const bool valid = dist >= 0;
        float d[4] = {0.f, 0.f, 0.f, 0.f};
        if (valid) {
            const h16* kp = Z + (size_t)(b * S + key) * ZP + ZC_KSLC + hk * 64;
#pragma unroll 4
            for (int i = 0; i < 64; ++i) { const float kvv = (float)kp[i];
#pragma unroll
                for (int g = 0; g < 4; ++g) d[g] += qs[g * 64 + i] * kvv; }
        }
        WSYNC();
#pragma unroll
        for (int g = 0; g < 4; ++g) {
            const float s = valid ? d[g] * 0.125f + rel_bias_of(rel_bias, hk * 4 + g, dist) : -INFINITY;
            const float mnew = fmaxf(ms[g], wave_max(s));
            const float p = valid ? expf(s - mnew) : 0.f;
            const float corr = expf(ms[g] - mnew);
            ls[g] = ls[g] * corr + wave_sum(p);
            os[g] *= corr; ms[g] = mnew;
            pb[g * 256 + lane] = p;
        }
        WSYNC();
        const int nk = min(64, qpos - n * 64 + 1);
        for (int j = 0; j < nk; ++j) {
            const float vv = (float)Z[(size_t)(b * S + n * 64 + j) * ZP + ZC_VSLC + hk * 64 + lane];
#pragma unroll
            for (int g = 0; g < 4; ++g) os[g] += pb[g * 256 + j] * vv;
        }
    }
    float ow[4] = {0.f, 0.f, 0.f, 0.f}, mw[4], lw[4] = {0.f, 0.f, 0.f, 0.f};
#pragma unroll
    for (int g = 0; g < 4; ++g) mw[g] = -INFINITY;
    for (int w = 0; w < 8; ++w) {
        const int pos = qpos - 511 + w * 64 + lane; const int dist = qpos - pos;
        float d[4] = {0.f, 0.f, 0.f, 0.f};
        if (pos >= 0) {
            const h16* kp = Z + (size_t)(b * S + pos) * ZP + ZC_KWIN + hk * 64;
#pragma unroll 4
            for (int i = 0; i < 64; ++i) { const float kvv = (float)kp[i];
#pragma unroll
                for (int g = 0; g < 4; ++g) d[g] += qs[g * 64 + i] * kvv; }
        }
        WSYNC();
#pragma unroll
        for (int g = 0; g < 4; ++g) {
            const float s = d[g] * 0.125f + rel_bias_of(rel_bias, hk * 4 + g, dist);
            const float mnew = fmaxf(mw[g], wave_max(s));
            const float p = expf(s - mnew);
            const float corr = expf(mw[g] - mnew);
            lw[g] = lw[g] * corr + wave_sum(p);
            ow[g] *= corr; mw[g] = mnew;
            pb[g * 256 + lane] = p;
        }
        WSYNC();
        const int p0 = qpos - 511 + w * 64;
        for (int j = 0; j < 64; ++j) {
            if (p0 + j < 0) continue;
            const float vv = (float)Z[(size_t)(b * S + p0 + j) * ZP + ZC_VWIN + hk * 64 + lane];
#pragma unroll
            for (int g = 0; g < 4; ++g) ow[g] += pb[g * 256 + j] * vv;
        }
    }
#pragma unroll
    for (int g = 0; g < 4; ++g) {
        const float o = gate[g][0] * oc[g] + gate[g][1] * os[g] / ls[g] + gate[g][2] * ow[g] / lw[g];
        OA[(size_t)m * 1024 + 512 + (hk * 4 + g) * 64 + lane] = (h16)o;
    }
}

DEVI void ph_attn(const h16* Z, const h16* QM, const h16* KVM, const h16* KR, const float* CS, const float* KC, const float* rel_bias, h16* OA, float* sm) {
    const int wave = threadIdx.x >> 6, gw = blockIdx.x * NWAVES + wave, NW = gridDim.x * NWAVES;
    float* wsm = sm + wave * 2048;
    const int n_mla = NB * 8 * S, n_nsa = NB * 2 * S;
    for (int it = gw; it < n_mla + n_nsa; it += NW) {
        if (it < n_mla) {
            const int qi = it / (NB * 8), r = it % (NB * 8); const int b = r >> 3, h = r & 7;
            mla_item(b, h, S - 1 - qi, QM, KVM, KR, CS, OA, wsm);
        } else {
            const int j = it - n_mla; const int qi = j / (NB * 2), r = j % (NB * 2); const int b = r >> 1, hk = r & 1;
            nsa_item(b, hk, S - 1 - qi, Z, KC, rel_bias, OA, wsm);
        }
    }
}

__global__ void __launch_bounds__(NTHREADS) mk_fwd(Params P) {
    cg::grid_group grid = cg::this_grid();
    extern __shared__ __attribute__((aligned(16))) unsigned char lds[];
    float* sm = (float*)lds;
    unsigned char* ws = P.ws;
    h16* XN = (h16*)(ws + WS_XN); h16* Z = (h16*)(ws + WS_Z); h16* QM = (h16*)(ws + WS_QM); h16* KVM = (h16*)(ws + WS_KVM);
    h16* KR = (h16*)(ws + WS_KR); h16* CQN = (h16*)(ws + WS_CQN); h16* CKVN = (h16*)(ws + WS_CKVN); float* KC = (float*)(ws + WS_KC);
    h16* OA = (h16*)(ws + WS_OA); float* CS = (float*)(ws + WS_CS);
    float* Y = (float*)(ws + WS_Y); h16* G16 = (h16*)(ws + WS_G); h16* A16 = (h16*)(ws + WS_A); float* F = (float*)(ws + WS_F); float* PP = (float*)(ws + WS_PP);
    const float* x_in = P.in[0]; const float* p_in = P.in[1]; const int* positions = (const int*)P.in[2]; const float* rel_bias = P.in[3];
    float* out = P.out;

    for (int l = 0; l < DEPTH; ++l) {
        const float* xcur = (l == 0) ? x_in : out;
        const float* g_attn_pre = P.in[4] + (size_t)l * DM; const float* g_attn_post = P.in[5] + (size_t)l * DM;
        const float* g_ffn_pre = P.in[6] + (size_t)l * DM; const float* g_ffn_post = P.in[7] + (size_t)l * DM;
        const float* w_in = P.in[8] + (size_t)l * DM * NZ;
        const float* q_norm = P.in[9] + (size_t)l * 256; const float* w_uq = P.in[10] + (size_t)l * 256 * 768;
        const float* kv_norm = P.in[11] + (size_t)l * 128; const float* w_ukv = P.in[12] + (size_t)l * 128 * 1024;
        const float* cmp_pos = P.in[13] + (size_t)l * 2 * 2048; const float* cmp_w1 = P.in[14] + (size_t)l * 2 * 2048 * 128; const float* cmp_w2 = P.in[15] + (size_t)l * 2 * 128 * 64;
        const float* w_o = P.in[16] + (size_t)l * DM * DM;
        const float* w_gate = P.in[17] + (size_t)l * DM * FF; const float* w_up = P.in[18] + (size_t)l * DM * FF;
        const float* conv_w = P.in[19] + (size_t)l * 3 * FF; const float* conv_b = P.in[20] + (size_t)l * FF;
        const float* w_down = P.in[21] + (size_t)l * FF * DM;
        const float* ple_proj = P.in[22] + (size_t)l * PLE * DM; const float* ple_gate = P.in[23] + (size_t)l * DM * DM;
        const float* p_l = p_in + (size_t)l * M * PLE;

        ph_norm1(xcur, g_attn_pre, XN);
        grid.sync();
        gemm_naive<h16>(XN, DM, w_in, NZ, DM, M, [=](int m, int n, float v) { Z[(size_t)m * ZP + n] = (h16)v; }, sm);
        grid.sync();
        ph_prep(Z, positions, q_norm, kv_norm, CQN, CKVN, KR, CS);
        ph_compress(Z, cmp_pos, cmp_w1, cmp_w2, KC, sm);
        grid.sync();
        gemm_naive<h16>(CQN, 256, w_uq, 768, 256, M, [=](int m, int n, float v) { QM[(size_t)m * 768 + n] = (h16)v; }, sm);
        gemm_naive<h16>(CKVN, 128, w_ukv, 1024, 128, M, [=](int m, int n, float v) { KVM[(size_t)m * 1024 + n] = (h16)v; }, sm);
        grid.sync();
        ph_attn(Z, QM, KVM, KR, CS, KC, rel_bias, OA, sm);
        grid.sync();
        gemm_naive<h16>(OA, DM, w_o, DM, DM, M, [=](int m, int n, float v) { Y[(size_t)m * DM + n] = v; }, sm);
        grid.sync();
        ph_post1(xcur, Y, g_attn_post, g_ffn_pre, out, XN);
        grid.sync();
        gemm_naive<h16>(XN, DM, w_gate, FF, DM, M, [=](int m, int n, float v) { G16[(size_t)m * FF + n] = (h16)v; }, sm);
        grid.sync();
        gemm_naive<h16>(XN, DM, w_up, FF, DM, M, [=](int m, int n, float v) {
            const int t = m & (S - 1);
            const float g0 = (float)G16[(size_t)m * FF + n];
            const float g1 = t >= 1 ? (float)G16[(size_t)(m - 1) * FF + n] : 0.f;
            const float g2 = t >= 2 ? (float)G16[(size_t)(m - 2) * FF + n] : 0.f;
            const float cv = conv_w[2 * FF + n] * g0 + conv_w[FF + n] * g1 + conv_w[n] * g2 + conv_b[n];
            A16[(size_t)m * FF + n] = (h16)(gelu_tanh(cv) * v);
        }, sm);
        grid.sync();
        gemm_naive<h16>(A16, FF, w_down, DM, FF, M, [=](int m, int n, float v) { F[(size_t)m * DM + n] = v; }, sm);
        grid.sync();
        ph_post2(F, g_ffn_post, out, XN);
        gemm_naive<float>(p_l, PLE, ple_proj, DM, PLE, M, [=](int m, int n, float v) { PP[(size_t)m * DM + n] = v; }, sm);
        grid.sync();
        gemm_naive<h16>(XN, DM, ple_gate, DM, DM, M, [=](int m, int n, float v) {
            const size_t idx = (size_t)m * DM + n;
            out[idx] = out[idx] + sigmoidf(v) * PP[idx];
        }, sm);
        grid.sync();
    }
}

extern "C" void kernel_launch(void* const* d_in, const int* in_sizes, int n_in, void* d_out, int out_size, void* d_ws, size_t ws_size, hipStream_t stream) {
    static int grid = 0;
    if (grid == 0) {
        int dev = 0, cus = 0, per_cu = 0;
        hipGetDevice(&dev);
        hipDeviceGetAttribute(&cus, hipDeviceAttributeMultiprocessorCount, dev);
        hipFuncSetAttribute((const void*)mk_fwd, hipFuncAttributeMaxDynamicSharedMemorySize, LDS_BYTES);
        hipOccupancyMaxActiveBlocksPerMultiprocessor(&per_cu, (const void*)mk_fwd, NTHREADS, LDS_BYTES);
        if (per_cu < 1) per_cu = 1;
        grid = cus * per_cu;
        fprintf(stderr, "kernel_launch: cus %d per_cu %d grid %d ws %zu\n", cus, per_cu, grid, ws_size);
    }
    Params p{};
    for (int i = 0; i < 24; ++i) p.in[i] = (const float*)d_in[i];
    p.out = (float*)d_out; p.ws = (unsigned char*)d_ws;
    void* args[] = {&p};
    hipError_t e = hipLaunchCooperativeKernel((void*)mk_fwd, dim3(grid), dim3(NTHREADS), args, LDS_BYTES, stream);
    if (e != hipSuccess) fprintf(stderr, "cooperative launch failed: %s (grid %d)\n", hipGetErrorString(e), grid);
}
```

```cpp
#include <hip/hip_runtime.h>
#include <hip/hip_cooperative_groups.h>
#include <cstdio>
#include <cstdint>
namespace cg = cooperative_groups;
typedef _Float16 h16;
#define DEVI __device__ __forceinline__
__device__ __forceinline__ int otid() { int t = threadIdx.x; asm volatile("" : "+v"(t)); return t; }
namespace pg8 {
#define PG8_LAS __attribute__((address_space(3)))
typedef unsigned short bf16_t;
typedef short bf16x8 __attribute__((ext_vector_type(8)));
typedef float f32x4 __attribute__((ext_vector_type(4)));
typedef unsigned u32x4 __attribute__((ext_vector_type(4)));
typedef _Float16 f16x8 __attribute__((ext_vector_type(8)));
constexpr int BM = 256, BK = 64, HALF = 128, HTB = HALF * BK * 2  , STAGE_BYTES = 8 * HTB, NXCD = 8, WGM = 8;

__host__ __device__ __forceinline__ int lds_byte(int r, int c) { const int st = (r >> 4) * 2 + (c >> 5), rr = r & 15, cc = c & 31, ob = rr * 64 + cc * 2; return st * 1024 + (ob ^ (((ob >> 9) & 1) << 5)); }
__host__ __device__ __forceinline__ void stage_rc(int b, int& R, int& C) { const int st = b / 1024, sb = b % 1024, swz = sb ^ (((sb >> 9) & 1) << 5); R = (st >> 1) * 16 + swz / 64; C = (st & 1) * 32 + (swz % 64) / 2; }
__host__ __device__ __forceinline__ int perm32(int rho) { const int n = rho >> 4, i = rho & 15; return 8 * (i >> 2) + 4 * n + (i & 3); }

struct Unit { int pm, pn; };
struct Gemm { const bf16_t* A; const bf16_t* Bt; int M, N, K; };

struct StaticOrder {
    int nM, nN, nwg, G, c;
    __host__ __device__ void init(int M, int N, int G_, int c_) { nM = M / BM; nN = N / BM; nwg = nM * nN; G = G_; c = c_; }
    __host__ __device__ bool next(int i, Unit& u) const {
        const long L = (long)i * G + c; if (L >= nwg) return false;
        int wgid = (int)L; { const int q = nwg / NXCD, r = nwg % NXCD, xcd = wgid % NXCD, off = wgid / NXCD; wgid = (xcd < r ? xcd * (q + 1) : r * (q + 1) + (xcd - r) * q) + off; }
        const int nig = WGM * nN, gid = wgid / nig, fm = gid * WGM, gsz = (nM - fm) < WGM ? (nM - fm) : WGM;
        u.pm = fm + ((wgid % nig) % gsz); u.pn = (wgid % nig) / gsz; return true;
    }
    __device__ __forceinline__ void a_ready(const Unit&) const {}
    __device__ __forceinline__ void done(const Unit&) const {}
};


template <class Epi, class Sched, bool ALIGN_EPI = false, bool SP2 = false>
__device__ __forceinline__ void gemm_phase(PG8_LAS unsigned char* lds, const Gemm g, const Sched& S, const Epi& E) {
    const int tid = otid(), wid = __builtin_amdgcn_readfirstlane(tid >> 6), lane = tid & 63, wr = wid >> 2, wc = wid & 3, fr = lane & 15, fq = lane >> 4;
    const int K = g.K, nt = K / BK;
    unsigned voffA[2], voffB[2];
#pragma unroll
    for (int i = 0; i < 2; ++i) { int R, C; stage_rc(tid * 16 + i * 8192, R, C); const int Rb = E.perm ? ((R & ~31) + perm32(R & 31)) : R;
        voffA[i] = (unsigned)(R * K + C) * 2u; voffB[i] = (unsigned)(Rb * K + C) * 2u; }
    const size_t kstep = (size_t)(BK * 2);
    const size_t hstep = (size_t)HALF * K * 2;
    const size_t tstep = 2 * hstep;
    const unsigned ldsw = (unsigned)wid * 1024u;
    const int aoff = lds_byte(wr * 64 + fr, fq * 8), boff = lds_byte(wc * 32 + fr, fq * 8);
#define PG8_SA(b, h) (((b) * 2 + (h)) * HTB)
#define PG8_SB(b, h) ((4 + (b) * 2 + (h)) * HTB)
#define PG8_STAGE(bufoff, gbase, voff) do { _Pragma("unroll") for (int _i = 0; _i < 2; ++_i) \
        __builtin_amdgcn_global_load_lds((const unsigned*)((const char*)(gbase) + (voff)[_i]), (PG8_LAS unsigned*)(lds + (bufoff) + ldsw + _i * 8192), 16, 0, 0); } while (0)
#define PG8_LDA(dst, b, h) do { _Pragma("unroll") for (int m = 0; m < 4; ++m) _Pragma("unroll") for (int k = 0; k < 2; ++k) dst[m][k] = *(const PG8_LAS bf16x8*)(lds + PG8_SA(b, h) + aoff + m * 2048 + k * 1024); } while (0)
#define PG8_LDB(dst, b, h) do { _Pragma("unroll") for (int n = 0; n < 2; ++n) _Pragma("unroll") for (int k = 0; k < 2; ++k) dst[n][k] = *(const PG8_LAS bf16x8*)(lds + PG8_SB(b, h) + boff + n * 2048 + k * 1024); } while (0)
#define PG8_MMA(ai, bj, At, Bt) do { __builtin_amdgcn_s_setprio(1); _Pragma("unroll") for (int m = 0; m < 4; ++m) _Pragma("unroll") for (int n = 0; n < 2; ++n) _Pragma("unroll") for (int k = 0; k < 2; ++k) \
        acc[ai][bj][m][n] = __builtin_amdgcn_mfma_f32_16x16x32_f16(__builtin_bit_cast(f16x8, Bt[n][k]), __builtin_bit_cast(f16x8, At[m][k]), acc[ai][bj][m][n], 0, 0, 0); __builtin_amdgcn_s_setprio(0); } while (0)
#define PG8_WAIT_V(n) asm volatile("s_waitcnt vmcnt(" #n ")" ::: "memory")
#define PG8_WAIT_L(n) asm volatile("s_waitcnt lgkmcnt(" #n ")" ::: "memory")
#define PG8_BAR __builtin_amdgcn_s_barrier()
#define PG8_SCHED __builtin_amdgcn_sched_barrier(0)
    Unit cur, nxt; int ui = 0;
    if (!S.next(0, cur)) return;
    f32x4 acc[2][2][4][2];
#pragma unroll
    for (int a = 0; a < 2; ++a)
#pragma unroll
        for (int b = 0; b < 2; ++b)
#pragma unroll
            for (int m = 0; m < 4; ++m)
#pragma unroll
                for (int n = 0; n < 2; ++n) acc[a][b][m][n] = (f32x4){0.f, 0.f, 0.f, 0.f};
    bf16x8 At[4][2], B0[2][2], B1[2][2];
    const char* cA = (const char*)g.A + (size_t)cur.pm * tstep; const char* cB = (const char*)g.Bt + (size_t)cur.pn * tstep;
    S.a_ready(cur);
    if constexpr (SP2) {
        PG8_STAGE(PG8_SB(0, 0), cB, voffB); PG8_STAGE(PG8_SB(0, 1), cB + hstep, voffB); PG8_STAGE(PG8_SA(0, 0), cA, voffA); PG8_STAGE(PG8_SA(0, 1), cA + hstep, voffA);
        if (wr == 1) PG8_BAR;
        PG8_WAIT_V(2); PG8_BAR;
        PG8_STAGE(PG8_SB(1, 0), cB + kstep, voffB); PG8_STAGE(PG8_SA(1, 0), cA + kstep, voffA); PG8_STAGE(PG8_SB(1, 1), cB + hstep + kstep, voffB);
        PG8_WAIT_V(6); PG8_BAR;
    } else {
        PG8_STAGE(PG8_SB(0, 0), cB, voffB); PG8_STAGE(PG8_SA(0, 0), cA, voffA); PG8_STAGE(PG8_SB(0, 1), cB + hstep, voffB); PG8_STAGE(PG8_SA(0, 1), cA + hstep, voffA);
        if (wr == 1) PG8_BAR;
        PG8_WAIT_V(4); PG8_BAR;
        PG8_STAGE(PG8_SB(1, 0), cB + kstep, voffB); PG8_STAGE(PG8_SA(1, 0), cA + kstep, voffA); PG8_STAGE(PG8_SB(1, 1), cB + hstep + kstep, voffB);
        PG8_WAIT_V(6); PG8_BAR;
    }
    for (;;) {
        const bool has_next = S.next(ui + 1, nxt);
        const char* nA = has_next ? (const char*)g.A + (size_t)nxt.pm * tstep : cA; const char* nB = has_next ? (const char*)g.Bt + (size_t)nxt.pn * tstep : cB;
        for (int t = 0; t < nt; t += 2) {
            const bool last = (t == nt - 2);
            const char* a1 = cA + (size_t)(t + 1) * kstep;
            const char* a2 = last ? nA : cA + (size_t)(t + 2) * kstep; const char* b2 = last ? nB : cB + (size_t)(t + 2) * kstep;
            const char* a3 = a2 + kstep; const char* b3 = b2 + kstep;
            if (last && has_next) S.a_ready(nxt);
            if constexpr (SP2) {
            PG8_LDB(B0, 0, 0); PG8_LDB(B1, 0, 1); PG8_SCHED; PG8_LDA(At, 0, 0); PG8_STAGE(PG8_SA(1, 1), a1 + hstep, voffA);
            PG8_WAIT_V(8); PG8_WAIT_L(0); PG8_BAR; PG8_MMA(0, 0, At, B0); PG8_MMA(0, 1, At, B1); PG8_BAR; PG8_SCHED;
            PG8_LDA(At, 0, 1); PG8_STAGE(PG8_SB(0, 0), b2, voffB); PG8_STAGE(PG8_SB(0, 1), b2 + hstep, voffB); PG8_STAGE(PG8_SA(0, 0), a2, voffA);
            PG8_WAIT_V(8); PG8_WAIT_L(0); PG8_BAR; PG8_MMA(1, 0, At, B0); PG8_MMA(1, 1, At, B1); PG8_BAR; PG8_SCHED;
            PG8_LDB(B0, 1, 0); PG8_LDB(B1, 1, 1); PG8_SCHED; PG8_LDA(At, 1, 0); PG8_STAGE(PG8_SA(0, 1), a2 + hstep, voffA);
            PG8_WAIT_V(8); PG8_WAIT_L(0); PG8_BAR; PG8_MMA(0, 0, At, B0); PG8_MMA(0, 1, At, B1); PG8_BAR; PG8_SCHED;
            PG8_LDA(At, 1, 1); PG8_STAGE(PG8_SB(1, 0), b3, voffB); PG8_STAGE(PG8_SB(1, 1), b3 + hstep, voffB); PG8_STAGE(PG8_SA(1, 0), a3, voffA);
            PG8_WAIT_V(8); PG8_WAIT_L(0); PG8_BAR; PG8_MMA(1, 0, At, B0); PG8_MMA(1, 1, At, B1); PG8_BAR; PG8_SCHED;
            } else {
            PG8_LDB(B0, 0, 0); PG8_SCHED; PG8_LDA(At, 0, 0); PG8_STAGE(PG8_SA(1, 1), a1 + hstep, voffA);
            PG8_WAIT_L(8); PG8_BAR; PG8_WAIT_L(0); PG8_MMA(0, 0, At, B0); PG8_BAR; PG8_SCHED;
            PG8_LDB(B1, 0, 1); PG8_STAGE(PG8_SB(0, 0), b2, voffB);
            PG8_BAR; PG8_WAIT_L(0); PG8_MMA(0, 1, At, B1); PG8_BAR;
            PG8_LDA(At, 0, 1); PG8_STAGE(PG8_SA(0, 0), a2, voffA);
            PG8_BAR; PG8_WAIT_L(0); PG8_MMA(1, 0, At, B0); PG8_BAR; PG8_SCHED;
            PG8_STAGE(PG8_SB(0, 1), b2 + hstep, voffB);
            PG8_WAIT_V(6); PG8_BAR; PG8_MMA(1, 1, At, B1); PG8_BAR;
            PG8_LDB(B0, 1, 0); PG8_SCHED; PG8_LDA(At, 1, 0); PG8_STAGE(PG8_SA(0, 1), a2 + hstep, voffA);
            PG8_WAIT_L(8); PG8_BAR; PG8_WAIT_L(0); PG8_MMA(0, 0, At, B0); PG8_BAR; PG8_SCHED;
            PG8_LDB(B1, 1, 1); PG8_STAGE(PG8_SB(1, 0), b3, voffB);
            PG8_BAR; PG8_WAIT_L(0); PG8_MMA(0, 1, At, B1); PG8_BAR;
            PG8_LDA(At, 1, 1); PG8_STAGE(PG8_SA(1, 0), a3, voffA);
            PG8_BAR; PG8_WAIT_L(0); PG8_MMA(1, 0, At, B0); PG8_BAR; PG8_SCHED;
            PG8_STAGE(PG8_SB(1, 1), b3 + hstep, voffB);
            PG8_WAIT_V(6); PG8_BAR; PG8_MMA(1, 1, At, B1); PG8_BAR;
            }
        }
        if constexpr (ALIGN_EPI) { if (wr == 0) PG8_BAR; }
        if constexpr (!Epi::AFTER_DRAIN) { E(acc, cur, wr, wc, fr, fq); S.done(cur); }
        if (!has_next) break;
#pragma unroll
        for (int a = 0; a < 2; ++a)
#pragma unroll
            for (int b = 0; b < 2; ++b)
#pragma unroll
                for (int m = 0; m < 4; ++m)
#pragma unroll
                    for (int n = 0; n < 2; ++n) acc[a][b][m][n] = (f32x4){0.f, 0.f, 0.f, 0.f};
        cur = nxt; cA = nA; cB = nB; ++ui;
        if constexpr (ALIGN_EPI) { if (wr == 1) PG8_BAR; }
    }
    PG8_WAIT_V(0);
    if constexpr (!ALIGN_EPI) { if (wr == 0) PG8_BAR; }
    PG8_BAR;
    if constexpr (Epi::AFTER_DRAIN) { E.fused(acc, cur, wr, wc, fr, fq, lds, wid, lane); S.done(cur); }
#undef PG8_SA
#undef PG8_SB
#undef PG8_STAGE
#undef PG8_LDA
#undef PG8_LDB
#undef PG8_MMA
#undef PG8_WAIT_V
#undef PG8_WAIT_L
#undef PG8_BAR
#undef PG8_SCHED
}
__device__ __forceinline__ unsigned pkh(float lo, float hi) {
    const _Float16 a = (_Float16)lo, b = (_Float16)hi;
    return (unsigned)__builtin_bit_cast(unsigned short, a) | ((unsigned)__builtin_bit_cast(unsigned short, b) << 16);
}
__device__ __forceinline__ u32x4 pkh8(const f32x4& v0, const f32x4& v1) { u32x4 w; w.x = pkh(v0[0], v0[1]); w.y = pkh(v0[2], v0[3]); w.z = pkh(v1[0], v1[1]); w.w = pkh(v1[2], v1[3]); return w; }
template <class F> struct Epi8 {
    static constexpr bool PERM = true, AFTER_DRAIN = false;
    F f;
    __device__ __forceinline__ void operator()(const f32x4 (&acc)[2][2][4][2], const Unit& u, int wr, int wc, int fr, int fq) const {
        const int row0 = u.pm * BM + wr * 64 + fr, col0 = u.pn * BM + wc * 32 + 8 * fq;
#pragma unroll
        for (int bj = 0; bj < 2; ++bj)
#pragma unroll
            for (int ai = 0; ai < 2; ++ai)
#pragma unroll
                for (int m = 0; m < 4; ++m) f(row0 + ai * HALF + m * 16, col0 + bj * HALF, acc[ai][bj][m][0], acc[ai][bj][m][1]);
    }
};
template <class F> struct Epi4 {
    static constexpr bool PERM = false, AFTER_DRAIN = false;
    F f;
    __device__ __forceinline__ void operator()(const f32x4 (&acc)[2][2][4][2], const Unit& u, int wr, int wc, int fr, int fq) const {
        const int row0 = u.pm * BM + wr * 64 + fr, col0 = u.pn * BM + wc * 32 + 4 * fq;
#pragma unroll
        for (int bj = 0; bj < 2; ++bj)
#pragma unroll
            for (int n = 0; n < 2; ++n)
#pragma unroll
                for (int ai = 0; ai < 2; ++ai)
#pragma unroll
                    for (int m = 0; m < 4; ++m) f(row0 + ai * HALF + m * 16, col0 + bj * HALF + n * 16, acc[ai][bj][m][n]);
    }
};
}
constexpr int NB = 4, S = 4096, DM = 1024, M = NB * S, DEPTH = 2;
constexpr int NZ = 1720, ZP = 1792;
constexpr int FF = 2816, PLE = 256;
constexpr float EPS = 1e-6f;
constexpr float NEGF = -1e30f;
constexpr int ZC_CQ = 0, ZC_CKV = 256, ZC_KR = 384, ZC_QN = 416, ZC_KCMP = 928, ZC_VCMP = 1056, ZC_KSLC = 1184,
              ZC_VSLC = 1312, ZC_KWIN = 1440, ZC_VWIN = 1568, ZC_GATE = 1696;
constexpr int NCMP = 255;

constexpr size_t MiB = 1u << 20;
constexpr size_t WS_CTL = 0, WS_WT = 1 * MiB, WS_XN = 27 * MiB, WS_Z = 59 * MiB, WS_QM = 115 * MiB, WS_KVM = 139 * MiB, WS_KR = 171 * MiB,
                 WS_CQN = 172 * MiB, WS_CKVN = 180 * MiB, WS_KC = 188 * MiB, WS_OA = 189 * MiB, WS_CS = 221 * MiB, WS_P16 = 235 * MiB;
constexpr size_t WS_Y = 59 * MiB, WS_G = 59 * MiB, WS_A = 147 * MiB, WS_F = 59 * MiB, WS_PP = 147 * MiB;
constexpr size_t WT_IN = 0, WT_UQ = WT_IN + 1792 * 1024, WT_UKV = WT_UQ + 768 * 256, WT_O = WT_UKV + 1024 * 256, WT_GATE = WT_O + 1024 * 1024,
                 WT_UP = WT_GATE + 2816 * 1024, WT_DOWN = WT_UP + 2816 * 1024, WT_PG = WT_DOWN + 1024 * 2816, WT_PP = WT_PG + 1024 * 1024, WT_END = WT_PP + 1024 * 256;
static_assert(WT_END * 2 <= 26 * MiB, "weights fit");
constexpr int LDS_BYTES = 147456;
constexpr int NTHREADS = 512, NWAVES = 8;

__device__ const unsigned char BUCKET_T[128] = {0, 1, 2, 3, 4, 5, 6, 7, 8, 9, 10, 11, 12, 13, 14, 15, 16, 16, 16, 17, 17, 18, 18, 18, 19, 19, 19, 20, 20, 20, 20, 21, 21, 21, 21, 22, 22, 22, 22, 22, 23, 23, 23, 23, 23, 23, 24, 24, 24, 24, 24, 24, 25, 25, 25, 25, 25, 25, 25, 26, 26, 26, 26, 26, 26, 26, 26, 27, 27, 27, 27, 27, 27, 27, 27, 27, 27, 28, 28, 28, 28, 28, 28, 28, 28, 28, 28, 29, 29, 29, 29, 29, 29, 29, 29, 29, 29, 29, 29, 30, 30, 30, 30, 30, 30, 30, 30, 30, 30, 30, 30, 30, 30, 31, 31, 31, 31, 31, 31, 31, 31, 31, 31, 31, 31, 31, 31, 31};
__device__ const double ROPE_INV[16] = {1.0, 0.5623413251903491, 0.31622776601683794, 0.1778279410038923, 0.1, 0.05623413251903491, 0.03162277660168379, 0.01778279410038923, 0.01, 0.005623413251903491, 0.0031622776601683794, 0.0017782794100389228, 0.001, 0.0005623413251903491, 0.00031622776601683794, 0.00017782794100389227};

struct Params { const float* in[24]; float* out; unsigned char* ws; };

DEVI float wave_max(float v) {
#pragma unroll
    for (int o = 32; o; o >>= 1) v = fmaxf(v, __shfl_xor(v, o));
    return v;
}
DEVI float wave_sum(float v) {
#pragma unroll
    for (int o = 32; o; o >>= 1) v += __shfl_xor(v, o);
    return v;
}
#define WSYNC() asm volatile("s_waitcnt lgkmcnt(0)" ::: "memory")
DEVI float gelu_tanh(float x) { return 0.5f * x * (1.f + tanhf(0.7978845608028654f * (x + 0.044715f * x * x * x))); }
DEVI float sigmoidf(float x) { return 1.f / (1.f + expf(-x)); }
DEVI float rel_bias_of(const float* rel_bias, int head, int dist) {
    const int bk = dist < 128 ? (int)BUCKET_T[dist] : 31;
    return rel_bias[bk * 8 + head];
}

template <typename TA, class Epi>
DEVI void gemm_naive(const TA* __restrict__ A, int lda, const float* __restrict__ W, int N, int K, int Mrows, Epi epi, float* sm) {
    float* As = sm;
    float* Bs = sm + 16 * 132;
    const int tid = otid(), tx = tid & 15, ty = tid >> 4;
    const int ntn = (N + 63) / 64, ntm = Mrows / 128;
    for (int tile = blockIdx.x; tile < ntm * ntn; tile += gridDim.x) {
        const int tm = tile / ntn, tn = tile % ntn;
        const int m0 = tm * 128, n0 = tn * 64;
        float acc[4][4];
#pragma unroll
        for (int i = 0; i < 4; ++i)
#pragma unroll
            for (int j = 0; j < 4; ++j) acc[i][j] = 0.f;
        for (int k0 = 0; k0 < K; k0 += 16) {
            {
                const int r = tid >> 2, kk = (tid & 3) * 4;
                const TA* ap = A + (size_t)(m0 + r) * lda + k0 + kk;
#pragma unroll
                for (int i = 0; i < 4; ++i) As[(kk + i) * 132 + r] = (float)ap[i];
            }
            {
                const int kk = tid >> 5, nn = (tid & 31) * 2;
#pragma unroll
                for (int i = 0; i < 2; ++i) { const int n = n0 + nn + i; Bs[kk * 68 + nn + i] = n < N ? W[(size_t)(k0 + kk) * N + n] : 0.f; }
            }
            __syncthreads();
#pragma unroll 2
            for (int kk = 0; kk < 16; ++kk) {
                float a[4], b[4];
#pragma unroll
                for (int i = 0; i < 4; ++i) a[i] = As[kk * 132 + ty * 4 + i];
#pragma unroll
                for (int j = 0; j < 4; ++j) b[j] = Bs[kk * 68 + tx * 4 + j];
#pragma unroll
                for (int i = 0; i < 4; ++i)
#pragma unroll
                    for (int j = 0; j < 4; ++j) acc[i][j] += a[i] * b[j];
            }
            __syncthreads();
        }
#pragma unroll
        for (int i = 0; i < 4; ++i)
#pragma unroll
            for (int j = 0; j < 4; ++j) { const int m = m0 + ty * 4 + i, n = n0 + tx * 4 + j; if (n < N) epi(m, n, acc[i][j]); }
    }
}

DEVI void ph_norm1(const float* x, const float* g, h16* XN) {
    const int lane = otid() & 63, gw = blockIdx.x * NWAVES + (otid() >> 6), NW = gridDim.x * NWAVES;
    for (int m = gw; m < M; m += NW) {
        const float* xr = x + (size_t)m * DM;
        float v[16]; float ss = 0.f;
#pragma unroll
        for (int i = 0; i < 16; ++i) { v[i] = xr[i * 64 + lane]; ss += v[i] * v[i]; }
        ss = wave_sum(ss);
        const float r = rsqrtf(ss * (1.f / DM) + EPS);
#pragma unroll
        for (int i = 0; i < 16; ++i) XN[(size_t)m * DM + i * 64 + lane] = (h16)(v[i] * r * g[i * 64 + lane]);
    }
}
DEVI void ph_prep(const h16* Z, const int* positions, const float* qn, const float* kvn, h16* CQN, h16* CKVN, h16* KR, float* CS) {
    const int lane = otid() & 63, gw = blockIdx.x * NWAVES + (otid() >> 6), NW = gridDim.x * NWAVES;
    for (int m = gw; m < M; m += NW) {
        const h16* zr = Z + (size_t)m * ZP;
        {
            float v[4]; float ss = 0.f;
#pragma unroll
            for (int i = 0; i < 4; ++i) { v[i] = (float)zr[ZC_CQ + i * 64 + lane]; ss += v[i] * v[i]; }
            ss = wave_sum(ss);
            const float r = rsqrtf(ss * (1.f / 256.f) + EPS);
#pragma unroll
            for (int i = 0; i < 4; ++i) CQN[(size_t)m * 256 + i * 64 + lane] = (h16)(v[i] * r * qn[i * 64 + lane]);
        }
        {
            float v[2]; float ss = 0.f;
#pragma unroll
            for (int i = 0; i < 2; ++i) { v[i] = (float)zr[ZC_CKV + i * 64 + lane]; ss += v[i] * v[i]; }
            ss = wave_sum(ss);
            const float r = rsqrtf(ss * (1.f / 128.f) + EPS);
#pragma unroll
            for (int i = 0; i < 2; ++i) { CKVN[(size_t)m * 256 + i * 64 + lane] = (h16)(v[i] * r * kvn[i * 64 + lane]); CKVN[(size_t)m * 256 + 128 + i * 64 + lane] = (h16)0.f; }
        }
        if (lane < 16) {
            const int pos = positions[m];
            double rev = (double)pos * ROPE_INV[lane] * 0.15915494309189535;
            rev -= rint(rev);
            const float fr = (float)rev;
            const float sn = __builtin_amdgcn_sinf(fr), cs = __builtin_amdgcn_cosf(fr);
            CS[(size_t)m * 32 + lane] = cs; CS[(size_t)m * 32 + 16 + lane] = sn;
            const float x1 = (float)zr[ZC_KR + lane], x2 = (float)zr[ZC_KR + 16 + lane];
            KR[(size_t)m * 32 + lane] = (h16)(x1 * cs - x2 * sn);
            KR[(size_t)m * 32 + 16 + lane] = (h16)(x2 * cs + x1 * sn);
        }
    }
}
DEVI void ph_post1(const float* x, const float* Y, const float* gpost, const float* gpre, float* out, h16* XN) {
    const int lane = otid() & 63, gw = blockIdx.x * NWAVES + (otid() >> 6), NW = gridDim.x * NWAVES;
    for (int m = gw; m < M; m += NW) {
        float y[16], v[16]; float ss = 0.f;
#pragma unroll
        for (int i = 0; i < 16; ++i) { y[i] = Y[(size_t)m * DM + i * 64 + lane]; ss += y[i] * y[i]; }
        ss = wave_sum(ss);
        const float r = rsqrtf(ss * (1.f / DM) + EPS);
        float s2 = 0.f;
#pragma unroll
        for (int i = 0; i < 16; ++i) { v[i] = x[(size_t)m * DM + i * 64 + lane] + y[i] * r * gpost[i * 64 + lane]; s2 += v[i] * v[i]; }
        s2 = wave_sum(s2);
        const float r2 = rsqrtf(s2 * (1.f / DM) + EPS);
#pragma unroll
        for (int i = 0; i < 16; ++i) { out[(size_t)m * DM + i * 64 + lane] = v[i]; XN[(size_t)m * DM + i * 64 + lane] = (h16)(v[i] * r2 * gpre[i * 64 + lane]); }
    }
}
DEVI void ph_post2(const float* F, const float* gpost, float* out, h16* X16) {
    const int lane = otid() & 63, gw = blockIdx.x * NWAVES + (otid() >> 6), NW = gridDim.x * NWAVES;
    for (int m = gw; m < M; m += NW) {
        float y[16]; float ss = 0.f;
#pragma unroll
        for (int i = 0; i < 16; ++i) { y[i] = F[(size_t)m * DM + i * 64 + lane]; ss += y[i] * y[i]; }
        ss = wave_sum(ss);
        const float r = rsqrtf(ss * (1.f / DM) + EPS);
#pragma unroll
        for (int i = 0; i < 16; ++i) {
            const float v = out[(size_t)m * DM + i * 64 + lane] + y[i] * r * gpost[i * 64 + lane];
            out[(size_t)m * DM + i * 64 + lane] = v; X16[(size_t)m * DM + i * 64 + lane] = (h16)v;
        }
    }
}

DEVI void ph_compress(const h16* Z, const float* cpos, const float* w1, const float* w2, h16* KC, float* sm) {
    float* xs = sm;
    float* part = sm + 2048;
    float* hs = sm + 2048 + 512;
    float* part2 = sm + 2048 + 512 + 128;
    const int tid = otid();
    const int nitems = 2 * NB * 2 * NCMP;
    for (int it = blockIdx.x; it < nitems; it += gridDim.x) {
        const int c = it % NCMP; int r = it / NCMP; const int hk = r & 1; r >>= 1; const int b = r % NB; const int kv = r / NB;
        const int col0 = (kv == 0 ? ZC_KCMP : ZC_VCMP) + hk * 64;
        for (int i = tid; i < 2048; i += NTHREADS) {
            const int l = i >> 6, d = i & 63;
            xs[i] = (float)Z[(size_t)(b * S + 16 * c + l) * ZP + col0 + d] + cpos[(size_t)kv * 2048 + i];
        }
        __syncthreads();
        {
            const int j = tid & 127, p = tid >> 7;
            const float* wp = w1 + (size_t)kv * 2048 * 128 + (size_t)(p * 512) * 128 + j;
            float a = 0.f;
#pragma unroll 4
            for (int i = 0; i < 512; ++i) a += xs[p * 512 + i] * wp[(size_t)i * 128];
            part[p * 128 + j] = a;
        }
        __syncthreads();
        if (tid < 128) hs[tid] = gelu_tanh(part[tid] + part[128 + tid] + part[256 + tid] + part[384 + tid]);
        __syncthreads();
        {
            const int d = tid & 63, p = tid >> 6;
            const float* wp = w2 + (size_t)kv * 128 * 64 + (size_t)(p * 16) * 64 + d;
            float a = 0.f;
#pragma unroll
            for (int j = 0; j < 16; ++j) a += hs[p * 16 + j] * wp[j * 64];
            part2[p * 64 + d] = a;
        }
        __syncthreads();
        if (tid < 64) {
            float a = 0.f;
#pragma unroll
            for (int p = 0; p < 8; ++p) a += part2[p * 64 + tid];
            KC[((((size_t)kv * NB + b) * 2 + hk) * 256 + c) * 64 + tid] = (h16)a;
            if (c == 0) KC[((((size_t)kv * NB + b) * 2 + hk) * 256 + 255) * 64 + tid] = (h16)0.f;
        }
        __syncthreads();
    }
}

DEVI void mla_item(int b, int h, int qpos, const h16* QM, const h16* KVM, const h16* KR, const float* CS, h16* OA, float* wsm) {
    const int lane = otid() & 63;
    const int m = b * S + qpos;
    float* qs = wsm; float* pb = wsm + 96;
    WSYNC();
    qs[lane] = (float)QM[(size_t)m * 768 + h * 96 + lane];
    if (lane < 16) {
        const float x1 = (float)QM[(size_t)m * 768 + h * 96 + 64 + lane], x2 = (float)QM[(size_t)m * 768 + h * 96 + 80 + lane];
        const float c = CS[(size_t)m * 32 + lane], s = CS[(size_t)m * 32 + 16 + lane];
        qs[64 + lane] = x1 * c - x2 * s; qs[80 + lane] = x2 * c + x1 * s;
    }
    WSYNC();
    float mrun = -INFINITY, l = 0.f, o = 0.f;
    const float scale = 0.10206207261596577f;
    for (int k0 = 0; k0 <= qpos; k0 += 64) {
        const int key = k0 + lane; const bool valid = key <= qpos;
        float s = -INFINITY;
        if (valid) {
            const h16* kp = KVM + (size_t)(b * S + key) * 1024 + h * 128; const h16* kr = KR + (size_t)(b * S + key) * 32;
            float d = 0.f;
#pragma unroll 8
            for (int i = 0; i < 64; ++i) d += qs[i] * (float)kp[i];
#pragma unroll 8
            for (int i = 0; i < 32; ++i) d += qs[64 + i] * (float)kr[i];
            s = d * scale;
        }
        const float mnew = fmaxf(mrun, wave_max(s));
        const float p = valid ? expf(s - mnew) : 0.f;
        const float corr = expf(mrun - mnew);
        l = l * corr + wave_sum(p);
        WSYNC(); pb[lane] = p; WSYNC();
        o *= corr;
        const int nk = min(64, qpos - k0 + 1);
        for (int j = 0; j < nk; ++j) o += pb[j] * (float)KVM[(size_t)(b * S + k0 + j) * 1024 + h * 128 + 64 + lane];
        mrun = mnew;
    }
    OA[(size_t)m * 1024 + h * 64 + lane] = (h16)(o / l);
}

DEVI void nsa_item(int b, int hk, int qpos, const h16* Z, const float* KC, const float* rel_bias, h16* OA, float* wsm) {
    const int lane = otid() & 63;
    const int m = b * S + qpos;
    float* qs = wsm;
    float* pb = wsm + 256;
    float* ib = wsm + 256 + 1024;
    const h16* zr = Z + (size_t)m * ZP;
    WSYNC();
#pragma unroll
    for (int g = 0; g < 4; ++g) qs[g * 64 + lane] = (float)zr[ZC_QN + (hk * 4 + g) * 64 + lane];
    WSYNC();
    float gate[4][3];
#pragma unroll
    for (int g = 0; g < 4; ++g)
#pragma unroll
        for (int j = 0; j < 3; ++j) gate[g][j] = sigmoidf((float)zr[ZC_GATE + (hk * 4 + g) * 3 + j]);
    const float* kc = KC + (((size_t)0 * NB + b) * 2 + hk) * 256 * 64;
    const float* vc = KC + (((size_t)1 * NB + b) * 2 + hk) * 256 * 64;
    float oc[4] = {0.f, 0.f, 0.f, 0.f};
    float impv = 0.f;
    if (qpos >= 31) {
        float sc[4][4];
#pragma unroll
        for (int cc = 0; cc < 4; ++cc) {
            const int c = cc * 64 + lane; const int dist = qpos - (16 * c + 31);
            const bool valid = (c < NCMP) && dist >= 0;
            float d[4] = {0.f, 0.f, 0.f, 0.f};
            if (valid) {
                const float* kp = kc + (size_t)c * 64;
#pragma unroll 4
                for (int i = 0; i < 64; ++i) { const float kvv = kp[i];
#pragma unroll
                    for (int g = 0; g < 4; ++g) d[g] += qs[g * 64 + i] * kvv; }
            }
#pragma unroll
            for (int g = 0; g < 4; ++g) sc[g][cc] = valid ? d[g] * 0.125f + rel_bias_of(rel_bias, hk * 4 + g, dist) : -INFINITY;
        }
#pragma unroll
        for (int g = 0; g < 4; ++g) {
            float mx = fmaxf(fmaxf(sc[g][0], sc[g][1]), fmaxf(sc[g][2], sc[g][3]));
            mx = wave_max(mx);
            float e[4]; float sum = 0.f;
#pragma unroll
            for (int cc = 0; cc < 4; ++cc) { e[cc] = expf(sc[g][cc] - mx); sum += e[cc]; }
            sum = wave_sum(sum);
            const float inv = 1.f / sum;
#pragma unroll
            for (int cc = 0; cc < 4; ++cc) pb[g * 256 + cc * 64 + lane] = e[cc] * inv;
        }
        WSYNC();
        const int cmax = min(NCMP, (qpos - 31) / 16 + 1);
        for (int c = 0; c < cmax; ++c) {
            const float vv = vc[(size_t)c * 64 + lane];
#pragma unroll
            for (int g = 0; g < 4; ++g) oc[g] += pb[g * 256 + c] * vv;
        }
        {
            const int n = lane;
#pragma unroll
            for (int g = 0; g < 4; ++g) {
                float a = pb[g * 256 + 4 * n] + pb[g * 256 + 4 * n + 1] + pb[g * 256 + 4 * n + 2];
                if (n > 0) a += 0.5f * pb[g * 256 + 4 * n - 1];
                if (4 * n + 3 < NCMP) a += 0.5f * pb[g * 256 + 4 * n + 3];
                impv += a;
            }
        }
    }
    const int qblk = qpos >> 6;
    unsigned long long selmask;
    {
        const int n = lane;
        float val = impv;
        if (n == 0 || n == qblk || n == qblk - 1) val = 1e30f;
        else if (n > qblk) val = NEGF;
        WSYNC(); ib[n] = val; WSYNC();
        int rank = 0;
        for (int j = 0; j < 64; ++j) { const float vj = ib[j]; rank += (vj > val || (vj == val && j < n)) ? 1 : 0; }
        selmask = __ballot(rank < 16);
    }
    float os[4] = {0.f, 0.f, 0.f, 0.f}, ms[4], ls[4] = {0.f, 0.f, 0.f, 0.f};
#pragma unroll
    for (int g = 0; g < 4; ++g) ms[g] = -INFINITY;
    for (int n = 0; n <= qblk; ++n) {
        if (!((selmask >> n) & 1ull)) continue;
        const int key = n * 64 + lane; const int dist = qpos - key; const bool valid = dist >= 0;
        float d[4] = {0.f, 0.f, 0.f, 0.f};
        if (valid) {
            const h16* kp = Z + (size_t)(b * S + key) * ZP + ZC_KSLC + hk * 64;
#pragma unroll 4
            for (int i = 0; i < 64; ++i) { const float kvv = (float)kp[i];
#pragma unroll
                for (int g = 0; g < 4; ++g) d[g] += qs[g * 64 + i] * kvv; }
        }
        WSYNC();
#pragma unroll
        for (int g = 0; g < 4; ++g) {
            const float s = valid ? d[g] * 0.125f + rel_bias_of(rel_bias, hk * 4 + g, dist) : -INFINITY;
            const float mnew = fmaxf(ms[g], wave_max(s));
            const float p = valid ? expf(s - mnew) : 0.f;
            const float corr = expf(ms[g] - mnew);
            ls[g] = ls[g] * corr + wave_sum(p);
            os[g] *= corr; ms[g] = mnew;
            pb[g * 256 + lane] = p;
        }
        WSYNC();
        const int nk = min(64, qpos - n * 64 + 1);
        for (int j = 0; j < nk; ++j) {
            const float vv = (float)Z[(size_t)(b * S + n * 64 + j) * ZP + ZC_VSLC + hk * 64 + lane];
#pragma unroll
            for (int g = 0; g < 4; ++g) os[g] += pb[g * 256 + j] * vv;
        }
    }
    float ow[4] = {0.f, 0.f, 0.f, 0.f}, mw[4], lw[4] = {0.f, 0.f, 0.f, 0.f};
#pragma unroll
    for (int g = 0; g < 4; ++g) mw[g] = -INFINITY;
    for (int w = 0; w < 8; ++w) {
        const int pos = qpos - 511 + w * 64 + lane; const int dist = qpos - pos;
        float d[4] = {0.f, 0.f, 0.f, 0.f};
        if (pos >= 0) {
            const h16* kp = Z + (size_t)(b * S + pos) * ZP + ZC_KWIN + hk * 64;
#pragma unroll 4
            for (int i = 0; i < 64; ++i) { const float kvv = (float)kp[i];
#pragma unroll
                for (int g = 0; g < 4; ++g) d[g] += qs[g * 64 + i] * kvv; }
        }
        WSYNC();
#pragma unroll
        for (int g = 0; g < 4; ++g) {
            const float s = d[g] * 0.125f + rel_bias_of(rel_bias, hk * 4 + g, dist);
            const float mnew = fmaxf(mw[g], wave_max(s));
            const float p = expf(s - mnew);
            const float corr = expf(mw[g] - mnew);
            lw[g] = lw[g] * corr + wave_sum(p);
            ow[g] *= corr; mw[g] = mnew;
            pb[g * 256 + lane] = p;
        }
        WSYNC();
        const int p0 = qpos - 511 + w * 64;
        for (int j = 0; j < 64; ++j) {
            if (p0 + j < 0) continue;
            const float vv = (float)Z[(size_t)(b * S + p0 + j) * ZP + ZC_VWIN + hk * 64 + lane];
#pragma unroll
            for (int g = 0; g < 4; ++g) ow[g] += pb[g * 256 + j] * vv;
        }
    }
#pragma unroll
    for (int g = 0; g < 4; ++g) {
        const float o = gate[g][0] * oc[g] + gate[g][1] * os[g] / ls[g] + gate[g][2] * ow[g] / lw[g];
        OA[(size_t)m * 1024 + 512 + (hk * 4 + g) * 64 + lane] = (h16)o;
    }
}

typedef _Float16 f16x8 __attribute__((ext_vector_type(8)));
typedef _Float16 f16x4 __attribute__((ext_vector_type(4)));
typedef _Float16 f16x2 __attribute__((ext_vector_type(2)));
typedef float f32x16 __attribute__((ext_vector_type(16)));
typedef short s16x4 __attribute__((ext_vector_type(4)));
typedef __attribute__((address_space(3))) unsigned char lds_u8;
DEVI int crow(int r, int hi) { return (r & 3) + 8 * (r >> 2) + 4 * hi; }
DEVI f16x8 cvt8_rtz(const f32x16& p, int base) {
    typedef __fp16 hp2 __attribute__((ext_vector_type(2)));
    const hp2 a = __builtin_amdgcn_cvt_pkrtz(p[base + 0], p[base + 1]), b = __builtin_amdgcn_cvt_pkrtz(p[base + 2], p[base + 3]),
              c = __builtin_amdgcn_cvt_pkrtz(p[base + 4], p[base + 5]), d = __builtin_amdgcn_cvt_pkrtz(p[base + 6], p[base + 7]);
    typedef unsigned u4 __attribute__((ext_vector_type(4)));
    u4 w; w.x = __builtin_bit_cast(unsigned, a); w.y = __builtin_bit_cast(unsigned, b); w.z = __builtin_bit_cast(unsigned, c); w.w = __builtin_bit_cast(unsigned, d);
    return __builtin_bit_cast(f16x8, w);
}
DEVI s16x4 ds_tr(const lds_u8* p) {
    typedef short v4i16_t __attribute__((ext_vector_type(4)));
    return __builtin_bit_cast(s16x4, __builtin_amdgcn_ds_read_tr16_b64_v4i16((__attribute__((address_space(3))) v4i16_t*)p));
}
DEVI f16x8 cat44(s16x4 lo, s16x4 hi) {
    typedef short s8 __attribute__((ext_vector_type(8)));
    const s8 v = {lo[0], lo[1], lo[2], lo[3], hi[0], hi[1], hi[2], hi[3]};
    return __builtin_bit_cast(f16x8, v);
}
template <int VSTR>
DEVI void softmax_pv(f32x16& p0, f32x16& p1, float& mrun, float& lrun, f32x16 (&o)[2], const lds_u8* Vt, int lane) {
    const int hi = lane >> 5;
    float mt = p0[0];
#pragma unroll
    for (int r = 1; r < 16; ++r) mt = fmaxf(mt, p0[r]);
#pragma unroll
    for (int r = 0; r < 16; ++r) mt = fmaxf(mt, p1[r]);
    mt = fmaxf(mt, __shfl_xor(mt, 32));
    const float mnew = fmaxf(mrun, mt);
    const float muse = (mnew == -INFINITY) ? 0.f : mnew;
    const float corr = __builtin_amdgcn_exp2f(mrun - muse);
    float ls = 0.f;
#pragma unroll
    for (int r = 0; r < 16; ++r) { p0[r] = __builtin_amdgcn_exp2f(p0[r] - muse); ls += p0[r]; }
#pragma unroll
    for (int r = 0; r < 16; ++r) { p1[r] = __builtin_amdgcn_exp2f(p1[r] - muse); ls += p1[r]; }
    lrun = lrun * corr + ls; mrun = mnew;
#pragma unroll
    for (int r = 0; r < 16; ++r) { o[0][r] *= corr; o[1][r] *= corr; }
    const int g = lane >> 4, i = lane & 15;
    const lds_u8* vb = Vt + (4 * hi + (i >> 2)) * VSTR + (16 * (g & 1) + 4 * (i & 3)) * 2;
#pragma unroll
    for (int t = 0; t < 2; ++t)
#pragma unroll
        for (int s = 0; s < 2; ++s) {
            const f16x8 pf = cvt8_rtz(t == 0 ? p0 : p1, 8 * s);
#pragma unroll
            for (int db = 0; db < 2; ++db) {
                const lds_u8* a = vb + (32 * t + 16 * s) * VSTR + db * 64;
                const s16x4 lo = ds_tr(a), hh = ds_tr(a + 8 * VSTR);
                o[db] = __builtin_amdgcn_mfma_f32_32x32x16_f16(cat44(lo, hh), pf, o[db], 0, 0, 0);
            }
        }
}

constexpr int MLA_KSTR = 208, AT_VSTR = 144;
constexpr int AT_KBUF = 64 * MLA_KSTR, AT_VBUF = 64 * AT_VSTR;
DEVI void mla_unit(int b, int h, int qb, const h16* __restrict__ QM, const h16* __restrict__ KVM, const h16* __restrict__ KR, const float* __restrict__ CS, h16* __restrict__ OA, lds_u8* lds) {
    const int tid = otid(), lane = tid & 63, wid = __builtin_amdgcn_readfirstlane(tid >> 6), r32 = lane & 31, hi = lane >> 5;
    const int qpos = qb * 256 + wid * 32 + r32; const size_t mq = (size_t)b * S + qpos;
    lds_u8* Kb = lds; lds_u8* Vb = lds + 2 * AT_KBUF;
    f16x8 qr[6];
    {
        const float qs = 0.10206207261596577f * 1.4426950408889634f;
        const h16* qp = QM + mq * 768 + h * 96;
#pragma unroll
        for (int d0 = 0; d0 < 4; ++d0) {
            const f16x8 v = *(const f16x8*)(qp + 16 * d0 + 8 * hi);
#pragma unroll
            for (int j = 0; j < 8; ++j) qr[d0][j] = (_Float16)((float)v[j] * qs);
        }
        const f16x8 x1 = *(const f16x8*)(qp + 64 + 8 * hi), x2 = *(const f16x8*)(qp + 80 + 8 * hi);
        const float* cs = CS + mq * 32 + 8 * hi;
#pragma unroll
        for (int j = 0; j < 8; ++j) {
            const float c = cs[j], s = cs[16 + j], a = (float)x1[j], bb = (float)x2[j];
            qr[4][j] = (_Float16)((a * c - bb * s) * qs); qr[5][j] = (_Float16)((bb * c + a * s) * qs);
        }
    }
    const int skey = tid >> 3, sch = tid & 7;
    const int rkey = tid >> 2, rch = tid & 3;
    const h16* kv_src = KVM + ((size_t)b * S + skey) * 1024 + h * 128 + sch * 8;
    const h16* kr_src = KR + ((size_t)b * S + (rkey & 63)) * 32 + rch * 8;
    const int kdst = skey * MLA_KSTR + sch * 16, rdst = (rkey & 63) * MLA_KSTR + 128 + rch * 16, vdst = skey * AT_VSTR + sch * 16;
    const int NT = 4 * qb + 4;
    uint4 rk, rv, rr;
    rk = *(const uint4*)(kv_src); rv = *(const uint4*)(kv_src + 64); rr = *(const uint4*)(kr_src);
    __syncthreads();
    *(uint4*)(Kb + kdst) = rk; *(uint4*)(Vb + vdst) = rv; if (tid < 256) *(uint4*)(Kb + rdst) = rr;
    __syncthreads();
    float mrun = -INFINITY, lrun = 0.f; f32x16 o[2];
#pragma unroll
    for (int r = 0; r < 16; ++r) { o[0][r] = 0.f; o[1][r] = 0.f; }
    for (int t = 0; t < NT; ++t) {
        const int cur = t & 1;
        if (t + 1 < NT) {
            const size_t off = (size_t)(t + 1) * 64;
            rk = *(const uint4*)(kv_src + off * 1024); rv = *(const uint4*)(kv_src + off * 1024 + 64); rr = *(const uint4*)(kr_src + off * 32);
        }
        const lds_u8* Kt = Kb + cur * AT_KBUF; const lds_u8* Vt = Vb + cur * AT_VBUF;
        f32x16 p0, p1;
#pragma unroll
        for (int r = 0; r < 16; ++r) { p0[r] = 0.f; p1[r] = 0.f; }
#pragma unroll
        for (int d0 = 0; d0 < 6; ++d0) {
            const f16x8 k0 = *(const f16x8*)(Kt + r32 * MLA_KSTR + (16 * d0 + 8 * hi) * 2);
            const f16x8 k1 = *(const f16x8*)(Kt + (32 + r32) * MLA_KSTR + (16 * d0 + 8 * hi) * 2);
            p0 = __builtin_amdgcn_mfma_f32_32x32x16_f16(k0, qr[d0], p0, 0, 0, 0);
            p1 = __builtin_amdgcn_mfma_f32_32x32x16_f16(k1, qr[d0], p1, 0, 0, 0);
        }
        if (t >= NT - 4) {
            const int kbase = t * 64;
#pragma unroll
            for (int r = 0; r < 16; ++r) { const int kk = kbase + crow(r, hi); if (kk > qpos) p0[r] = -INFINITY; if (kk + 32 > qpos) p1[r] = -INFINITY; }
        }
        softmax_pv<AT_VSTR>(p0, p1, mrun, lrun, o, Vt, lane);
        if (t + 1 < NT) {
            lds_u8* Kn = Kb + (cur ^ 1) * AT_KBUF; lds_u8* Vn = Vb + (cur ^ 1) * AT_VBUF;
            *(uint4*)(Kn + kdst) = rk; *(uint4*)(Vn + vdst) = rv; if (tid < 256) *(uint4*)(Kn + rdst) = rr;
        }
        __syncthreads();
    }
    lrun += __shfl_xor(lrun, 32);
    const float inv = 1.f / lrun;
    h16* op = OA + mq * 1024 + h * 64;
#pragma unroll
    for (int db = 0; db < 2; ++db)
#pragma unroll
        for (int a = 0; a < 4; ++a) {
            uint2 w; w.x = pg8::pkh(o[db][4 * a] * inv, o[db][4 * a + 1] * inv); w.y = pg8::pkh(o[db][4 * a + 2] * inv, o[db][4 * a + 3] * inv);
            *(uint2*)(op + 32 * db + 8 * a + 4 * hi) = w;
        }
}

constexpr int NSA_IMP = 36864, NSA_SELM = NSA_IMP + 16384, NSA_LUT = NSA_SELM + 512, NSA_ESUF = NSA_LUT + 8 * 128 * 4, NSA_LDS_END = NSA_ESUF + 8 * 132 * 4;
static_assert(2 * AT_KBUF + 2 * AT_VBUF <= NSA_LUT, "MLA staging must not overwrite the bias tables");
DEVI void nsa_tables(const float* rel_bias, lds_u8* lds) {
    float* LUT = (float*)(lds + NSA_LUT); float* ESUF = (float*)(lds + NSA_ESUF);
    const int tid = otid();
    for (int k = tid; k < 8 * 128; k += NTHREADS) { const int h = k >> 7, d = k & 127; LUT[k] = rel_bias[(int)BUCKET_T[d] * 8 + h] * 1.4426950408889634f; }
    __syncthreads();
    if (tid < 8) {
        const float e31 = __builtin_amdgcn_exp2f(LUT[tid * 128 + 127]);
        float acc = 384.f * e31;
        ESUF[tid * 132 + 128] = acc;
        for (int d = 127; d >= 0; --d) { acc += __builtin_amdgcn_exp2f(LUT[tid * 128 + d]); ESUF[tid * 132 + d] = acc; }
        ESUF[tid * 132 + 129] = e31;
    }
    __syncthreads();
}
DEVI void qk64(const lds_u8* Kt, const f16x8 (&qr)[4], f32x16& p0, f32x16& p1, int r32, int hi) {
#pragma unroll
    for (int d0 = 0; d0 < 4; ++d0) {
        const f16x8 k0 = *(const f16x8*)(Kt + r32 * AT_VSTR + (16 * d0 + 8 * hi) * 2);
        const f16x8 k1 = *(const f16x8*)(Kt + (32 + r32) * AT_VSTR + (16 * d0 + 8 * hi) * 2);
        p0 = __builtin_amdgcn_mfma_f32_32x32x16_f16(k0, qr[d0], p0, 0, 0, 0);
        p1 = __builtin_amdgcn_mfma_f32_32x32x16_f16(k1, qr[d0], p1, 0, 0, 0);
    }
}
DEVI void pv64(const f32x16& p0, const f32x16& p1, f32x16 (&o)[2], const lds_u8* Vt, int lane) {
    const int hi = lane >> 5, g = lane >> 4, i = lane & 15;
    const lds_u8* vb = Vt + (4 * hi + (i >> 2)) * AT_VSTR + (16 * (g & 1) + 4 * (i & 3)) * 2;
#pragma unroll
    for (int t = 0; t < 2; ++t)
#pragma unroll
        for (int s = 0; s < 2; ++s) {
            const f16x8 pf = cvt8_rtz(t == 0 ? p0 : p1, 8 * s);
#pragma unroll
            for (int db = 0; db < 2; ++db) {
                const lds_u8* a = vb + (32 * t + 16 * s) * AT_VSTR + db * 64;
                const s16x4 lo = ds_tr(a), hh = ds_tr(a + 8 * AT_VSTR);
                o[db] = __builtin_amdgcn_mfma_f32_32x32x16_f16(cat44(lo, hh), pf, o[db], 0, 0, 0);
            }
        }
}
DEVI void add_bias_lut(f32x16& p0, f32x16& p1, const float* LUTh, int dist0, int hi) {
#pragma unroll
    for (int r = 0; r < 16; ++r) {
        const int d0 = dist0 - crow(r, hi), d1 = d0 - 32;
        p0[r] += LUTh[min(max(d0, 0), 127)];
        p1[r] += LUTh[min(max(d1, 0), 127)];
    }
}
DEVI unsigned long long wave_or64(unsigned long long v) {
    unsigned lo = (unsigned)v, hi = (unsigned)(v >> 32);
#pragma unroll
    for (int o = 32; o; o >>= 1) { lo |= __shfl_xor(lo, o); hi |= __shfl_xor(hi, o); }
    return ((unsigned long long)hi << 32) | lo;
}
DEVI void nsa_unit(int b, int hk, int qblk, const h16* __restrict__ Z, const h16* __restrict__ KC16, h16* __restrict__ OA, lds_u8* lds) {
    const int tid = otid(), lane = tid & 63, wid = __builtin_amdgcn_readfirstlane(tid >> 6), r32 = lane & 31, hi = lane >> 5;
    const int g = wid >> 1, qi = 32 * (wid & 1) + r32, qpos = 64 * qblk + qi, head = hk * 4 + g;
    const size_t mq = (size_t)b * S + qpos;
    lds_u8* Kb = lds; lds_u8* Vb = lds + 2 * AT_VBUF;
    float* IMP = (float*)(lds + NSA_IMP); unsigned long long* SELM = (unsigned long long*)(lds + NSA_SELM);
    const float* LUTh = (const float*)(lds + NSA_LUT) + head * 128; const float* ESUFh = (const float*)(lds + NSA_ESUF) + head * 132;
    const float c31 = LUTh[127];
    f16x8 qr[4];
    {
        const float qs = 0.125f * 1.4426950408889634f;
        const h16* qp = Z + mq * ZP + ZC_QN + head * 64;
#pragma unroll
        for (int d0 = 0; d0 < 4; ++d0) {
            const f16x8 v = *(const f16x8*)(qp + 16 * d0 + 8 * hi);
#pragma unroll
            for (int j = 0; j < 8; ++j) qr[d0][j] = (_Float16)((float)v[j] * qs);
        }
    }
    float gate_c, gate_s, gate_w;
    {
        const h16* gp = Z + mq * ZP + ZC_GATE + head * 3;
        gate_c = sigmoidf((float)gp[0]); gate_s = sigmoidf((float)gp[1]); gate_w = sigmoidf((float)gp[2]);
    }
    const int skey = tid >> 3, sch = tid & 7;
    const int sdst = skey * AT_VSTR + sch * 16;
    uint4 rk, rv;
    f32x16 oacc[2];
#pragma unroll
    for (int r = 0; r < 16; ++r) { oacc[0][r] = 0.f; oacc[1][r] = 0.f; }

    __syncthreads();
    for (int k = tid; k < 4096; k += NTHREADS) IMP[k] = 0.f;

    const int NTc = (qblk >> 4) + 1;
    const h16* kc_src = KC16 + ((size_t)(0 * NB + b) * 2 + hk) * 256 * 64 + skey * 64 + sch * 8;
    const h16* vc_src = KC16 + ((size_t)(1 * NB + b) * 2 + hk) * 256 * 64 + skey * 64 + sch * 8;
    float mc = -INFINITY, lc = 0.f;
#pragma nounroll
    for (int pass = 0; pass < 2; ++pass) {
        const float mcu = (mc == -INFINITY) ? 0.f : mc;
        const float invl = lc > 0.f ? 1.f / lc : 0.f;
        rk = *(const uint4*)(kc_src); rv = *(const uint4*)(vc_src);
        __syncthreads();
        *(uint4*)(Kb + sdst) = rk; *(uint4*)(Vb + sdst) = rv;
        __syncthreads();
#pragma nounroll
        for (int t = 0; t < NTc; ++t) {
            const int cur = t & 1;
            if (t + 1 < NTc) { rk = *(const uint4*)(kc_src + (size_t)(t + 1) * 64 * 64); rv = *(const uint4*)(vc_src + (size_t)(t + 1) * 64 * 64); }
            const lds_u8* Kt = Kb + cur * AT_VBUF; const lds_u8* Vt = Vb + cur * AT_VBUF;
            f32x16 p0, p1;
#pragma unroll
            for (int r = 0; r < 16; ++r) { p0[r] = 0.f; p1[r] = 0.f; }
            qk64(Kt, qr, p0, p1, r32, hi);
#pragma unroll
            for (int r = 0; r < 16; ++r) {
                const int d0 = qpos - 31 - 16 * (64 * t + crow(r, hi)), d1 = d0 - 16 * 32;
                p0[r] = d0 >= 0 ? p0[r] + LUTh[min(d0, 127)] : -INFINITY;
                p1[r] = d1 >= 0 ? p1[r] + LUTh[min(d1, 127)] : -INFINITY;
            }
            if (pass == 0) {
                float mt = p0[0];
#pragma unroll
                for (int r = 1; r < 16; ++r) mt = fmaxf(mt, p0[r]);
#pragma unroll
                for (int r = 0; r < 16; ++r) mt = fmaxf(mt, p1[r]);
                mt = fmaxf(mt, __shfl_xor(mt, 32));
                const float mnew = fmaxf(mc, mt), muse = (mnew == -INFINITY) ? 0.f : mnew;
                float ls = 0.f;
#pragma unroll
                for (int r = 0; r < 16; ++r) ls += __builtin_amdgcn_exp2f(p0[r] - muse) + __builtin_amdgcn_exp2f(p1[r] - muse);
                lc = lc * __builtin_amdgcn_exp2f(mc - muse) + ls; mc = mnew;
            } else {
#pragma unroll
                for (int r = 0; r < 16; ++r) { p0[r] = __builtin_amdgcn_exp2f(p0[r] - mcu) * invl; p1[r] = __builtin_amdgcn_exp2f(p1[r] - mcu) * invl; }
#pragma unroll
                for (int a = 0; a < 4; ++a) {
                    { const int n = 16 * t + 2 * a + hi; const float hx = 0.5f * p0[4 * a + 3];
                      __hip_atomic_fetch_add(IMP + qi * 64 + n, p0[4 * a] + p0[4 * a + 1] + p0[4 * a + 2] + hx, __ATOMIC_RELAXED, __HIP_MEMORY_SCOPE_WORKGROUP);
                      if (n + 1 < 64) __hip_atomic_fetch_add(IMP + qi * 64 + n + 1, hx, __ATOMIC_RELAXED, __HIP_MEMORY_SCOPE_WORKGROUP); }
                    { const int n = 16 * t + 8 + 2 * a + hi; const float hx = 0.5f * p1[4 * a + 3];
                      __hip_atomic_fetch_add(IMP + qi * 64 + n, p1[4 * a] + p1[4 * a + 1] + p1[4 * a + 2] + hx, __ATOMIC_RELAXED, __HIP_MEMORY_SCOPE_WORKGROUP);
                      if (n + 1 < 64) __hip_atomic_fetch_add(IMP + qi * 64 + n + 1, hx, __ATOMIC_RELAXED, __HIP_MEMORY_SCOPE_WORKGROUP); }
                }
                pv64(p0, p1, oacc, Vt, lane);
            }
            if (t + 1 < NTc) { *(uint4*)(Kb + (cur ^ 1) * AT_VBUF + sdst) = rk; *(uint4*)(Vb + (cur ^ 1) * AT_VBUF + sdst) = rv; }
            __syncthreads();
        }
        if (pass == 0) lc += __shfl_xor(lc, 32);
    }
#pragma unroll
    for (int r = 0; r < 16; ++r) { oacc[0][r] *= gate_c; oacc[1][r] *= gate_c; }
    for (int k = 0; k < 8; ++k) {
        const int q = wid * 8 + k, n = lane, qp = 64 * qblk + q;
        (void)qp;
        float val = IMP[q * 64 + n];
        if (n == 0 || n == qblk || n == qblk - 1) val = 1e30f; else if (n > qblk) val = NEGF;
        int rank = 0;
        for (int j = 0; j < 64; ++j) { const float vj = __shfl(val, j); rank += (vj > val || (vj == val && j < n)) ? 1 : 0; }
        const unsigned long long msk = __ballot(rank < 16);
        if (lane == 0) SELM[q] = msk;
    }
    __syncthreads();
    const unsigned long long causal_bits = (qblk >= 63) ? ~0ull : ((2ull << qblk) - 1ull);
    const unsigned long long mymask = SELM[qi] & causal_bits;
    const unsigned long long WU = wave_or64(mymask);
    const unsigned long long U = wave_or64(SELM[lane]) & causal_bits;
    {
        const h16* ks_src = Z + ((size_t)b * S + skey) * ZP + ZC_KSLC + hk * 64 + sch * 8;
        const h16* vs_src = Z + ((size_t)b * S + skey) * ZP + ZC_VSLC + hk * 64 + sch * 8;
        float ms = -INFINITY, ls = 0.f; f32x16 os[2];
#pragma unroll
        for (int r = 0; r < 16; ++r) { os[0][r] = 0.f; os[1][r] = 0.f; }
        unsigned long long rem = U;
        int n = __builtin_ctzll(rem); rem &= rem - 1;
        rk = *(const uint4*)(ks_src + (size_t)n * 64 * ZP); rv = *(const uint4*)(vs_src + (size_t)n * 64 * ZP);
        *(uint4*)(Kb + sdst) = rk; *(uint4*)(Vb + sdst) = rv;
        __syncthreads();
        int cur = 0;
        for (;;) {
            const bool has_next = rem != 0ull;
            int nn = 0;
            if (has_next) { nn = __builtin_ctzll(rem); rem &= rem - 1; rk = *(const uint4*)(ks_src + (size_t)nn * 64 * ZP); rv = *(const uint4*)(vs_src + (size_t)nn * 64 * ZP); }
            if ((WU >> n) & 1ull) {
                const lds_u8* Kt = Kb + cur * AT_VBUF; const lds_u8* Vt = Vb + cur * AT_VBUF;
                const int delta = qblk - n;
                f32x16 p0, p1;
                const float ci = delta >= 3 ? c31 : 0.f;
#pragma unroll
                for (int r = 0; r < 16; ++r) { p0[r] = ci; p1[r] = ci; }
                qk64(Kt, qr, p0, p1, r32, hi);
                if (delta < 3) add_bias_lut(p0, p1, LUTh, 64 * delta + qi, hi);
                const bool sel = (mymask >> n) & 1ull;
#pragma unroll
                for (int r = 0; r < 16; ++r) {
                    const int kk = crow(r, hi);
                    if (!sel || (delta == 0 && kk > qi)) p0[r] = -INFINITY;
                    if (!sel || (delta == 0 && kk + 32 > qi)) p1[r] = -INFINITY;
                }
                softmax_pv<AT_VSTR>(p0, p1, ms, ls, os, Vt, lane);
            }
            if (has_next) { *(uint4*)(Kb + (cur ^ 1) * AT_VBUF + sdst) = rk; *(uint4*)(Vb + (cur ^ 1) * AT_VBUF + sdst) = rv; }
            __syncthreads();
            if (!has_next) break;
            n = nn; cur ^= 1;
        }
        ls += __shfl_xor(ls, 32);
        const float sc = gate_s / ls;
#pragma unroll
        for (int r = 0; r < 16; ++r) { oacc[0][r] += sc * os[0][r]; oacc[1][r] += sc * os[1][r]; }
    }
    {
        const h16* kw_src = Z + ((size_t)b * S + skey) * ZP + ZC_KWIN + hk * 64 + sch * 8;
        const h16* vw_src = Z + ((size_t)b * S + skey) * ZP + ZC_VWIN + hk * 64 + sch * 8;
        float mw = -INFINITY, lw = 0.f; f32x16 ow[2];
#pragma unroll
        for (int r = 0; r < 16; ++r) { ow[0][r] = 0.f; ow[1][r] = 0.f; }
        const int j0 = qblk >= 8 ? 0 : 8 - qblk;
        { const int kb = qblk - 8 + j0; rk = *(const uint4*)(kw_src + (size_t)kb * 64 * ZP); rv = *(const uint4*)(vw_src + (size_t)kb * 64 * ZP); }
        *(uint4*)(Kb + sdst) = rk; *(uint4*)(Vb + sdst) = rv;
        __syncthreads();
        int cur = 0;
        for (int j = j0; j <= 8; ++j) {
            if (j < 8) { const int kb = qblk - 7 + j; rk = *(const uint4*)(kw_src + (size_t)kb * 64 * ZP); rv = *(const uint4*)(vw_src + (size_t)kb * 64 * ZP); }
            const lds_u8* Kt = Kb + cur * AT_VBUF; const lds_u8* Vt = Vb + cur * AT_VBUF;
            const int delta = 8 - j;
            f32x16 p0, p1;
            const float ci = delta >= 3 ? c31 : 0.f;
#pragma unroll
            for (int r = 0; r < 16; ++r) { p0[r] = ci; p1[r] = ci; }
            qk64(Kt, qr, p0, p1, r32, hi);
            if (delta < 3) add_bias_lut(p0, p1, LUTh, 64 * delta + qi, hi);
            if (delta == 0 || delta == 8) {
#pragma unroll
                for (int r = 0; r < 16; ++r) {
                    const int kk = crow(r, hi);
                    const bool m0 = delta == 0 ? (kk > qi) : (kk <= qi);
                    const bool m1 = delta == 0 ? (kk + 32 > qi) : (kk + 32 <= qi);
                    if (m0) p0[r] = -INFINITY;
                    if (m1) p1[r] = -INFINITY;
                }
            }
            softmax_pv<AT_VSTR>(p0, p1, mw, lw, ow, Vt, lane);
            if (j < 8) { *(uint4*)(Kb + (cur ^ 1) * AT_VBUF + sdst) = rk; *(uint4*)(Vb + (cur ^ 1) * AT_VBUF + sdst) = rv; }
            __syncthreads();
            cur ^= 1;
        }
        lw += __shfl_xor(lw, 32);
        if (qpos < 511) {
            const int d0 = qpos + 1;
            const float E = d0 <= 128 ? ESUFh[d0] : (float)(512 - d0) * ESUFh[129];
            lw += E * __builtin_amdgcn_exp2f(-mw);
        }
        const float sc = gate_w / lw;
#pragma unroll
        for (int r = 0; r < 16; ++r) { oacc[0][r] += sc * ow[0][r]; oacc[1][r] += sc * ow[1][r]; }
    }
    h16* op = OA + mq * 1024 + 512 + head * 64;
#pragma unroll
    for (int db = 0; db < 2; ++db)
#pragma unroll
        for (int a = 0; a < 4; ++a) {
            uint2 w; w.x = pg8::pkh(oacc[db][4 * a], oacc[db][4 * a + 1]); w.y = pg8::pkh(oacc[db][4 * a + 2], oacc[db][4 * a + 3]);
            *(uint2*)(op + 32 * db + 8 * a + 4 * hi) = w;
        }
}

DEVI void ph_attn(const h16* Z, const h16* QM, const h16* KVM, const h16* KR, const float* CS, const h16* KC16, const float* rel_bias, h16* OA, float* sm) {
    lds_u8* lds = (lds_u8*)sm;
    nsa_tables(rel_bias, lds);
    for (int pi = blockIdx.x; pi < 256; pi += gridDim.x) {
        const int bh = pi >> 3, s = pi & 7;
        mla_unit(bh >> 3, bh & 7, 15 - s, QM, KVM, KR, CS, OA, lds);
        mla_unit(bh >> 3, bh & 7, s, QM, KVM, KR, CS, OA, lds);
    }
    for (int idx = blockIdx.x; idx < 512; idx += gridDim.x) {
        const int r = idx & 7, a = (idx >> 3) & 31;
        const int qblk = idx < 256 ? 63 - a : a;
        nsa_unit(r >> 1, r & 1, qblk, Z, KC16, OA, lds);
    }
}
DEVI void convert_item(const float* __restrict__ W, int K, int N, int Kp, h16* __restrict__ WT, int kb, int nb, float* scr, int lane) {
    const int k0 = kb * 64, n0 = nb * 32;
#pragma unroll 8
    for (int i = 0; i < 32; ++i) {
        const int kk = 2 * i + (lane >> 5), n = n0 + (lane & 31), k = k0 + kk;
        scr[kk * 33 + (lane & 31)] = (k < K && n < N) ? W[(size_t)k * N + n] : 0.f;
    }
    WSYNC();
    const int c = lane & 7;
#pragma unroll
    for (int j = 0; j < 4; ++j) {
        const int n = (lane >> 3) + 8 * j; const float* s = scr + (8 * c) * 33 + n;
        uint4 o; o.x = pg8::pkh(s[0], s[33]); o.y = pg8::pkh(s[66], s[99]); o.z = pg8::pkh(s[132], s[165]); o.w = pg8::pkh(s[198], s[231]);
        *(uint4*)(WT + (size_t)(n0 + n) * Kp + k0 + 8 * c) = o;
    }
    WSYNC();
}
DEVI void ph_convert(const Params& P, int l, h16* WT, h16* P16, float* sm) {
    const int lane = otid() & 63, wave = otid() >> 6, gw = blockIdx.x * NWAVES + wave, NW = gridDim.x * NWAVES;
    float* scr = sm + wave * (64 * 33);
    const int   midx[9] = {8, 10, 12, 16, 17, 18, 21, 23, 22};
    const int   mK[9]   = {1024, 256, 128, 1024, 1024, 1024, 2816, 1024, 256};
    const int   mN[9]   = {NZ, 768, 1024, 1024, FF, FF, 1024, 1024, 1024};
    const int   mKp[9]  = {1024, 256, 256, 1024, 1024, 1024, 2816, 1024, 256};
    const int   mNp[9]  = {1792, 768, 1024, 1024, FF, FF, 1024, 1024, 1024};
    const size_t moff[9] = {WT_IN, WT_UQ, WT_UKV, WT_O, WT_GATE, WT_UP, WT_DOWN, WT_PG, WT_PP};
    int total = 0;
#pragma unroll
    for (int i = 0; i < 9; ++i) total += (mKp[i] / 64) * (mNp[i] / 32);
    for (int it = gw; it < total; it += NW) {
        int r = it;
#pragma unroll
        for (int i = 0; i < 9; ++i) {
            const int cnt = (mKp[i] / 64) * (mNp[i] / 32);
            if (r >= 0 && r < cnt) {
                const int nblk = mNp[i] / 32;
                convert_item(P.in[midx[i]] + (size_t)l * mK[i] * mN[i], mK[i], mN[i], mKp[i], WT + moff[i], r / nblk, r % nblk, scr, lane);
            }
            r -= cnt;
        }
    }
    const float* pl = P.in[1] + (size_t)l * M * PLE;
    for (size_t i = (size_t)(blockIdx.x * NTHREADS + otid()) * 4; i < (size_t)M * PLE; i += (size_t)gridDim.x * NTHREADS * 4) {
        const float4 v = *(const float4*)(pl + i);
        uint2 o; o.x = pg8::pkh(v.x, v.y); o.y = pg8::pkh(v.z, v.w);
        *(uint2*)(P16 + i) = o;
    }
}

typedef __attribute__((address_space(3))) unsigned char lds_u8;
DEVI float gelu_fast(float x) {
    const float u = 0.7978845608028654f * (x + 0.044715f * x * x * x);
    return x * __builtin_amdgcn_rcpf(1.f + __builtin_amdgcn_exp2f(-2.885390081777927f * u));
}
enum { K_H16 = 0, K_F32 = 1, K_UP = 2, K_PLE = 3 };
struct EpiSw {
    static constexpr bool AFTER_DRAIN = false;
    int kind; bool perm;
    void* dst; int ld;
    const void* aux0; const float* aux1; const float* aux2;
    typedef pg8::f32x4 f32x4; typedef pg8::u32x4 u32x4;
    __device__ __forceinline__ void operator()(const f32x4 (&acc)[2][2][4][2], const pg8::Unit& u, int wr, int wc, int fr, int fq) const {
        using namespace pg8;
        const int row0 = u.pm * BM + wr * 64 + fr;
        if (kind == K_H16) {
            h16* D = (h16*)dst; const int col0 = u.pn * BM + wc * 32 + 8 * fq;
#pragma unroll
            for (int ai = 0; ai < 2; ++ai)
#pragma unroll
                for (int m = 0; m < 4; ++m)
#pragma unroll
                    for (int bj = 0; bj < 2; ++bj) *(u32x4*)(D + (size_t)(row0 + ai * HALF + m * 16) * ld + col0 + bj * HALF) = pkh8(acc[ai][bj][m][0], acc[ai][bj][m][1]);
        } else if (kind == K_F32) {
            float* D = (float*)dst; const int col0 = u.pn * BM + wc * 32 + 4 * fq;
#pragma unroll
            for (int ai = 0; ai < 2; ++ai)
#pragma unroll
                for (int m = 0; m < 4; ++m)
#pragma unroll
                    for (int bj = 0; bj < 2; ++bj)
#pragma unroll
                        for (int n = 0; n < 2; ++n) *(f32x4*)(D + (size_t)(row0 + ai * HALF + m * 16) * ld + col0 + bj * HALF + n * 16) = acc[ai][bj][m][n];
        } else if (kind == K_UP) {
            typedef _Float16 f16x8 __attribute__((ext_vector_type(8)));
            h16* D = (h16*)dst; const h16* G = (const h16*)aux0; const float* conv_w = aux1; const float* conv_b = aux2;
            const int col0 = u.pn * BM + wc * 32 + 8 * fq;
#pragma unroll
            for (int bj = 0; bj < 2; ++bj) {
                const int col = col0 + bj * HALF;
#pragma unroll
                for (int ai = 0; ai < 2; ++ai)
#pragma unroll
                    for (int m = 0; m < 4; ++m) {
                        int row = row0 + ai * HALF + m * 16; asm volatile("" : "+v"(row)); const int t = row & (S - 1);
                        const h16* gp = G + (size_t)row * FF + col;
                        const f16x8 z8 = {0, 0, 0, 0, 0, 0, 0, 0};
                        const f16x8 g0 = *(const f16x8*)gp;
                        const f16x8 g1 = t >= 1 ? *(const f16x8*)(gp - FF) : z8;
                        const f16x8 g2 = t >= 2 ? *(const f16x8*)(gp - 2 * FF) : z8;
                        float a[8];
#pragma unroll
                        for (int hh = 0; hh < 2; ++hh) {
                            const f32x4 w0 = *(const f32x4*)(conv_w + col + 4 * hh), w1 = *(const f32x4*)(conv_w + FF + col + 4 * hh), w2 = *(const f32x4*)(conv_w + 2 * FF + col + 4 * hh), cb = *(const f32x4*)(conv_b + col + 4 * hh);
#pragma unroll
                            for (int j = 0; j < 4; ++j) {
                                const float cv = w2[j] * (float)g0[4 * hh + j] + w1[j] * (float)g1[4 * hh + j] + w0[j] * (float)g2[4 * hh + j] + cb[j];
                                a[4 * hh + j] = gelu_fast(cv) * acc[ai][bj][m][hh][j];
                            }
                        }
                        u32x4 w; w.x = pkh(a[0], a[1]); w.y = pkh(a[2], a[3]); w.z = pkh(a[4], a[5]); w.w = pkh(a[6], a[7]);
                        *(u32x4*)(D + (size_t)row * FF + col) = w;
                        asm volatile("" ::: "memory");
                    }
            }
        } else {
            float* D = (float*)dst; const float* PPp = (const float*)aux0; const int col0 = u.pn * BM + wc * 32 + 4 * fq;
#pragma unroll
            for (int ai = 0; ai < 2; ++ai)
#pragma unroll
                for (int m = 0; m < 4; ++m)
#pragma unroll
                    for (int bj = 0; bj < 2; ++bj)
#pragma unroll
                        for (int n = 0; n < 2; ++n) {
                            int rowp = row0 + ai * HALF + m * 16; asm volatile("" : "+v"(rowp)); const size_t idx = (size_t)rowp * DM + col0 + bj * HALF + n * 16;
                            const f32x4 xo = *(const f32x4*)(D + idx), pp = *(const f32x4*)(PPp + idx), v = acc[ai][bj][m][n];
                            f32x4 o;
#pragma unroll
                            for (int j = 0; j < 4; ++j) o[j] = xo[j] + pp[j] * __builtin_amdgcn_rcpf(1.f + __builtin_amdgcn_exp2f(-1.4426950408889634f * v[j]));
                            *(f32x4*)(D + idx) = o;
                            if (n) asm volatile("" ::: "memory");
                        }
        }
    }
};

constexpr int NOPS = 14;
__global__ void __launch_bounds__(NTHREADS, 2) mk_fwd(Params P) {
    cg::grid_group grid = cg::this_grid();
    extern __shared__ __attribute__((aligned(16))) unsigned char lds[];
    float* sm = (float*)lds;
    lds_u8* lds3 = (lds_u8*)lds;
    unsigned char* ws = P.ws;
    float* out = P.out;
#pragma nounroll
    for (int step = 0; step < DEPTH * NOPS; ++step) {
        const int l = step / NOPS, op = step - l * NOPS;
        h16* WT = (h16*)(ws + WS_WT);
        h16* XN = (h16*)(ws + WS_XN); h16* Z = (h16*)(ws + WS_Z);
        const float* xcur = (l == 0) ? P.in[0] : out;
        if (op == 0) {
            ph_convert(P, l, WT, (h16*)(ws + WS_P16), sm);
            ph_norm1(xcur, P.in[4] + (size_t)l * DM, XN);
        } else if (op == 2) {
            ph_prep(Z, (const int*)P.in[2], P.in[9] + (size_t)l * 256, P.in[11] + (size_t)l * 128, (h16*)(ws + WS_CQN), (h16*)(ws + WS_CKVN), (h16*)(ws + WS_KR), (float*)(ws + WS_CS));
            ph_compress(Z, P.in[13] + (size_t)l * 2 * 2048, P.in[14] + (size_t)l * 2 * 2048 * 128, P.in[15] + (size_t)l * 2 * 128 * 64, (h16*)(ws + WS_KC), sm);
        } else if (op == 5) {
            ph_attn(Z, (const h16*)(ws + WS_QM), (const h16*)(ws + WS_KVM), (const h16*)(ws + WS_KR), (const float*)(ws + WS_CS), (const h16*)(ws + WS_KC), P.in[3], (h16*)(ws + WS_OA), sm);
        } else if (op == 7) {
            ph_post1(xcur, (const float*)(ws + WS_Y), P.in[5] + (size_t)l * DM, P.in[6] + (size_t)l * DM, out, XN);
        } else if (op == 11) {
            ph_post2((const float*)(ws + WS_F), P.in[7] + (size_t)l * DM, out, XN);
        } else {
            const h16* A; const h16* Bt; int N, K; EpiSw E; E.aux0 = nullptr; E.aux1 = nullptr; E.aux2 = nullptr;
            switch (op) {
                case 1:  A = XN; Bt = WT + WT_IN; N = 1792; K = 1024; E.kind = K_H16; E.perm = true; E.dst = Z; E.ld = ZP; break;
                case 3:  A = (const h16*)(ws + WS_CQN); Bt = WT + WT_UQ; N = 768; K = 256; E.kind = K_H16; E.perm = true; E.dst = ws + WS_QM; E.ld = 768; break;
                case 4:  A = (const h16*)(ws + WS_CKVN); Bt = WT + WT_UKV; N = 1024; K = 256; E.kind = K_H16; E.perm = true; E.dst = ws + WS_KVM; E.ld = 1024; break;
                case 6:  A = (const h16*)(ws + WS_OA); Bt = WT + WT_O; N = 1024; K = 1024; E.kind = K_F32; E.perm = false; E.dst = ws + WS_Y; E.ld = DM; break;
                case 8:  A = XN; Bt = WT + WT_GATE; N = FF; K = 1024; E.kind = K_H16; E.perm = true; E.dst = ws + WS_G; E.ld = FF; break;
                case 9:  A = XN; Bt = WT + WT_UP; N = FF; K = 1024; E.kind = K_UP; E.perm = true; E.dst = ws + WS_A; E.ld = FF; E.aux0 = ws + WS_G; E.aux1 = P.in[19] + (size_t)l * 3 * FF; E.aux2 = P.in[20] + (size_t)l * FF; break;
                case 10: A = (const h16*)(ws + WS_A); Bt = WT + WT_DOWN; N = 1024; K = FF; E.kind = K_F32; E.perm = false; E.dst = ws + WS_F; E.ld = DM; break;
                case 12: A = (const h16*)(ws + WS_P16); Bt = WT + WT_PP; N = 1024; K = 256; E.kind = K_F32; E.perm = false; E.dst = ws + WS_PP; E.ld = DM; break;
                default: A = XN; Bt = WT + WT_PG; N = 1024; K = 1024; E.kind = K_PLE; E.perm = false; E.dst = out; E.ld = DM; E.aux0 = ws + WS_PP; break;
            }
            pg8::Gemm g{(const pg8::bf16_t*)A, (const pg8::bf16_t*)Bt, M, N, K}; pg8::StaticOrder So; So.init(M, N, (int)gridDim.x, (int)blockIdx.x);
            pg8::gemm_phase<EpiSw, pg8::StaticOrder, true, true>(lds3, g, So, E);
        }
        if (op != 3 && op != 11) grid.sync();
    }
}

extern "C" void kernel_launch(void* const* d_in, const int* in_sizes, int n_in, void* d_out, int out_size, void* d_ws, size_t ws_size, hipStream_t stream) {
    static int grid = 0;
    if (grid == 0) {
        int dev = 0, cus = 0, per_cu = 0;
        (void)hipGetDevice(&dev);
        (void)hipDeviceGetAttribute(&cus, hipDeviceAttributeMultiprocessorCount, dev);
        (void)hipFuncSetAttribute((const void*)mk_fwd, hipFuncAttributeMaxDynamicSharedMemorySize, LDS_BYTES);
        (void)hipOccupancyMaxActiveBlocksPerMultiprocessor(&per_cu, (const void*)mk_fwd, NTHREADS, LDS_BYTES);
        if (per_cu < 1) per_cu = 1;
        grid = cus * per_cu;
        fprintf(stderr, "kernel_launch: cus %d per_cu %d grid %d ws %zu\n", cus, per_cu, grid, ws_size);
    }
    Params p{};
    for (int i = 0; i < 24; ++i) p.in[i] = (const float*)d_in[i];
    p.out = (float*)d_out; p.ws = (unsigned char*)d_ws;
    void* args[] = {&p};
    hipError_t e = hipLaunchCooperativeKernel((void*)mk_fwd, dim3(grid), dim3(NTHREADS), args, LDS_BYTES, stream);
    if (e != hipSuccess) fprintf(stderr, "cooperative launch failed: %s (grid %d)\n", hipGetErrorString(e), grid);
}
```
